# Optimizing an MI355X kernel written in HIP

```python
import jax, jax.numpy as jnp
from jax import lax
import numpy as np

D_MODEL = 1024
BATCH = 2
SEQ = 8192
DEPTH = 2
DEC_BATCH = 4
DEC_SEQ = 8192
PAST_LEN = 128

N_EVEN = (DEPTH + 1) // 2
N_ODD = DEPTH // 2
D_FF = 4 * D_MODEL
RMS_EPS = 1e-6
GRID_W = 64
Q_BLOCK = 128
RWKV_DIM = D_MODEL // 2
RWKV_HEAD = 64
RWKV_HEADS = RWKV_DIM // RWKV_HEAD
DECAY_LORA = 64
ICLR_LORA = 64
GATE_LORA = 128
GN_EPS = 64e-5
HEAD_DIM = 64
N_Q_HEADS = (D_MODEL // 2) // HEAD_DIM
N_KV_HEADS = 2
GQA_GROUP = N_Q_HEADS // N_KV_HEADS
ROPE_THETA = 10000.0
AXIS_PAIRS = HEAD_DIM // 4
S5_GROUP = 16
S5_GROUPS = D_MODEL // S5_GROUP
S5_STATE = 64
RWKV_SPLITS = (RWKV_DIM, RWKV_DIM, RWKV_DIM, DECAY_LORA, DECAY_LORA, ICLR_LORA, GATE_LORA)
RWKV_IN_WIDTH = sum(RWKV_SPLITS)
ATT_SPLITS = (N_Q_HEADS * HEAD_DIM, N_KV_HEADS * HEAD_DIM, N_KV_HEADS * HEAD_DIM)
IN_WIDTH = RWKV_IN_WIDTH + sum(ATT_SPLITS)

kernel_name = 'hybrid_rwkv7_axialgqa_s5_encoder'


def _split(z, sizes):
    return jnp.split(z, [int(s) for s in np.cumsum(sizes)[:-1]], axis=-1)


def _rms_norm(x, g):
    xf = x.astype(jnp.float32)
    y = xf * lax.rsqrt(jnp.mean(jnp.square(xf), axis=-1, keepdims=True) + RMS_EPS)
    return (y * g.astype(jnp.float32)).astype(x.dtype)


def _sqrelu_mlp(h, w_up, w_down):
    return jnp.square(jax.nn.relu(h @ w_up)) @ w_down


def _centred_shift(h, mu):
    prev = jnp.pad(h[:, :-1], ((0, 0), (1, 0), (0, 0)))
    nxt = jnp.pad(h[:, 1:], ((0, 0), (0, 1), (0, 0)))
    return h + mu * (0.5 * (prev + nxt) - h)


def _wkv_scan(r, w, k, v, a, b):
    bsz, _, nh, n = r.shape
    xs = tuple(jnp.moveaxis(z.astype(jnp.float32), 1, 0) for z in (r, w, k, v, a, b))

    def step(S, inp):
        r_t, w_t, k_t, v_t, a_t, b_t = inp
        sa = jnp.einsum('bhvk,bhk->bhv', S, a_t)
        S = S * w_t[:, :, None, :] + sa[..., None] * b_t[:, :, None, :] + v_t[..., None] * k_t[:, :, None, :]
        return S, jnp.einsum('bhvk,bhk->bhv', S, r_t)

    S0 = jnp.zeros((bsz, nh, n, n), jnp.float32)
    _, y = lax.scan(step, S0, xs)
    return jnp.moveaxis(y, 0, 1)


def _rwkv7_bidir(h, p, i):
    bsz, T, _ = h.shape
    f32 = jnp.float32
    h = _centred_shift(h, p['hyb_shift_mu'][i])
    r, k, v, hw_f, hw_b, ha, hg = _split(h, RWKV_SPLITS)

    def heads(z):
        return z.astype(f32).reshape(bsz, T, RWKV_HEADS, RWKV_HEAD)

    def decay(w0, w_up, hw):
        wl = (w0 + jnp.tanh(hw) @ w_up).astype(f32)
        return heads(jnp.exp(-jnp.exp(-jax.nn.softplus(-wl) - 0.5)))

    w_f = decay(p['rwkv_w0_f'][i], p['rwkv_w_up_f'][i], hw_f)
    w_b = decay(p['rwkv_w0_b'][i], p['rwkv_w_up_b'][i], hw_b)
    a = jax.nn.sigmoid((p['rwkv_a0'][i] + ha @ p['rwkv_a_up'][i]).astype(f32))
    g = jax.nn.sigmoid(hg) @ p['rwkv_g_up'][i]
    kk = heads(k * p['rwkv_k_k'][i])
    kk = kk / jnp.maximum(jnp.sqrt(jnp.sum(jnp.square(kk), axis=-1, keepdims=True)), 1e-12)
    k = heads(k.astype(f32) * (1.0 + (a - 1.0) * p['rwkv_k_a'][i].astype(f32)))
    r = heads(r)
    v = heads(v)
    rem = -kk
    add = kk * heads(a)
    flip = lambda z: jnp.flip(z, axis=1)
    y = _wkv_scan(r, w_f, k, v, rem, add) + flip(
        _wkv_scan(flip(r), flip(w_b), flip(k), flip(v), flip(rem), flip(add)))
    mean = jnp.mean(y, axis=-1, keepdims=True)
    var = jnp.mean(jnp.square(y - mean), axis=-1, keepdims=True)
    y = ((y - mean) * lax.rsqrt(var + GN_EPS)).reshape(bsz, T, RWKV_DIM)
    y = y * p['rwkv_lnx_g'][i].astype(f32) + p['rwkv_lnx_b'][i].astype(f32)
    bonus = jnp.sum(r * k * p['rwkv_r_k'][i].astype(f32), axis=-1, keepdims=True) * v
    y = (y + bonus.reshape(bsz, T, RWKV_DIM)) * g.astype(f32)
    return y.astype(h.dtype)


def _axial_rope(T):
    rows = T // GRID_W
    row_ids = jnp.repeat(jnp.arange(rows, dtype=jnp.float32), GRID_W)
    col_ids = jnp.tile(jnp.arange(GRID_W, dtype=jnp.float32), rows)
    inv_freq = ROPE_THETA ** (-jnp.arange(AXIS_PAIRS, dtype=jnp.float32) / AXIS_PAIRS)
    ang = jnp.concatenate([row_ids[:, None] * inv_freq, col_ids[:, None] * inv_freq], axis=-1)
    return jnp.cos(ang), jnp.sin(ang)


def _apply_rope(x, cos, sin):
    xf = x.astype(jnp.float32).reshape(*x.shape[:-1], HEAD_DIM // 2, 2)
    x1, x2 = xf[..., 0], xf[..., 1]
    c = cos[None, :, None, :]
    s = sin[None, :, None, :]
    out = jnp.stack([x1 * c - x2 * s, x1 * s + x2 * c], axis=-1)
    return out.reshape(x.shape).astype(x.dtype)


def _block_attention(q, k, v):
    bsz, T = q.shape[:2]
    nb = T // Q_BLOCK
    qb = q.reshape(bsz, nb, Q_BLOCK, N_KV_HEADS, GQA_GROUP, HEAD_DIM).transpose(1, 0, 2, 3, 4, 5)
    scale = HEAD_DIM ** -0.5

    def one_block(qblk):
        s = jnp.einsum('bqhgd,bkhd->bhgqk', qblk, k).astype(jnp.float32) * scale
        pr = jax.nn.softmax(s, axis=-1).astype(v.dtype)
        return jnp.einsum('bhgqk,bkhd->bqhgd', pr, v)

    o = lax.map(one_block, qb)
    return o.transpose(1, 0, 2, 3, 4, 5).reshape(bsz, T, N_Q_HEADS * HEAD_DIM)


def _axial_gqa(h, p, i):
    bsz, T, _ = h.shape
    q, k, v = _split(h, ATT_SPLITS)
    q = _rms_norm(q.reshape(bsz, T, N_Q_HEADS, HEAD_DIM), p['att_q_norm'][i])
    k = _rms_norm(k.reshape(bsz, T, N_KV_HEADS, HEAD_DIM), p['att_k_norm'][i])
    v = v.reshape(bsz, T, N_KV_HEADS, HEAD_DIM)
    cos, sin = _axial_rope(T)
    return _block_attention(_apply_rope(q, cos, sin), _apply_rope(k, cos, sin), v)


def _hybrid_mixer(hn, p, i):
    h = hn @ p['hyb_w_in'][i]
    y_a = _rwkv7_bidir(h[..., :RWKV_IN_WIDTH], p, i)
    y_b = _axial_gqa(h[..., RWKV_IN_WIDTH:], p, i)
    return jnp.concatenate([y_a, y_b], axis=-1) @ p['hyb_w_out'][i]


def _s5_scan(bu_re, bu_im, lam_re, lam_im, log_dt, reverse):
    dt = jnp.exp(log_dt.astype(jnp.float32))[:, None]
    lam_re = lam_re.astype(jnp.float32)
    lam_im = lam_im.astype(jnp.float32)
    mag = jnp.exp(lam_re * dt)
    lb_re, lb_im = mag * jnp.cos(lam_im * dt), mag * jnp.sin(lam_im * dt)
    nr, ni = lb_re - 1.0, lb_im
    den = jnp.square(lam_re) + jnp.square(lam_im)
    c_re = (nr * lam_re + ni * lam_im) / den
    c_im = (ni * lam_re - nr * lam_im) / den
    b_re = c_re * bu_re - c_im * bu_im
    b_im = c_re * bu_im + c_im * bu_re
    a_re = jnp.broadcast_to(lb_re, b_re.shape)
    a_im = jnp.broadcast_to(lb_im, b_re.shape)

    def combine(x, y):
        a1r, a1i, b1r, b1i = x
        a2r, a2i, b2r, b2i = y
        return (a2r * a1r - a2i * a1i, a2r * a1i + a2i * a1r,
                a2r * b1r - a2i * b1i + b2r, a2r * b1i + a2i * b1r + b2i)

    _, _, s_re, s_im = lax.associative_scan(combine, (a_re, a_im, b_re, b_im), reverse=reverse, axis=1)
    return s_re, s_im


def _s5_mixer(u, p, i):
    bsz, T, _ = u.shape
    f32 = jnp.float32
    ug = u.astype(f32).reshape(bsz, T, S5_GROUPS, S5_GROUP)
    bu_re = jnp.einsum('btgc,gpc->btgp', ug, p['s5_b_re'][i].astype(f32))
    bu_im = jnp.einsum('btgc,gpc->btgp', ug, p['s5_b_im'][i].astype(f32))
    y = u.astype(f32) * p['s5_d'][i].astype(f32)
    for sfx, rev in (('f', False), ('b', True)):
        s_re, s_im = _s5_scan(bu_re, bu_im, p['s5_lam_re_' + sfx][i], p['s5_lam_im_' + sfx][i],
                              p['s5_log_dt_' + sfx][i], rev)
        yc = (jnp.einsum('btgp,gcp->btgc', s_re, p['s5_c_re_' + sfx][i].astype(f32))
              - jnp.einsum('btgp,gcp->btgc', s_im, p['s5_c_im_' + sfx][i].astype(f32)))
        y = y + yc.reshape(bsz, T, D_MODEL)
    z = jax.nn.gelu(y)
    z = z * jax.nn.sigmoid(z @ p['s5_glu_w'][i].astype(f32) + p['s5_glu_b'][i].astype(f32))
    return z.astype(u.dtype)


def _trunk(x, p):
    for layer in range(DEPTH):
        i = layer // 2
        hn = _rms_norm(x, p['mix_norm'][layer])
        if layer % 2 == 0:
            x = x + _hybrid_mixer(hn, p, i)
        else:
            x = x + _s5_mixer(hn, p, i)
        x = x + _sqrelu_mlp(_rms_norm(x, p['ffn_norm'][layer]), p['ffn_up'][layer], p['ffn_down'][layer])
    return x


def setup_inputs(seed: int = 0) -> dict:
    key = jax.random.key(seed)
    ks = iter(jax.random.split(key, 48))

    def nrm(shape, scale):
        return scale * jax.random.normal(next(ks), shape, jnp.float32)

    def unif(shape, lo, hi):
        return jax.random.uniform(next(ks), shape, jnp.float32, lo, hi)

    E, O, L = N_EVEN, N_ODD, DEPTH
    G, P, GC = S5_GROUPS, S5_STATE, S5_GROUP
    n_idx = jnp.arange(P, dtype=jnp.float32)
    return {
        'x_prompt': nrm((BATCH, SEQ, D_MODEL), 1.0),
        'x_sample': nrm((DEC_BATCH, DEC_SEQ, D_MODEL), 1.0),
        'mix_norm': 1.0 + nrm((L, D_MODEL), 0.02),
        'ffn_norm': 1.0 + nrm((L, D_MODEL), 0.02),
        'ffn_up': nrm((L, D_MODEL, D_FF), D_MODEL ** -0.5),
        'ffn_down': nrm((L, D_FF, D_MODEL), D_FF ** -0.5),
        'hyb_w_in': nrm((E, D_MODEL, IN_WIDTH), D_MODEL ** -0.5),
        'hyb_shift_mu': unif((E, RWKV_IN_WIDTH), 0.0, 1.0),
        'rwkv_w0_f': unif((E, RWKV_DIM), -6.0, 1.0),
        'rwkv_w_up_f': nrm((E, DECAY_LORA, RWKV_DIM), 0.1),
        'rwkv_w0_b': unif((E, RWKV_DIM), -6.0, 1.0),
        'rwkv_w_up_b': nrm((E, DECAY_LORA, RWKV_DIM), 0.1),
        'rwkv_a0': nrm((E, RWKV_DIM), 0.1),
        'rwkv_a_up': nrm((E, ICLR_LORA, RWKV_DIM), ICLR_LORA ** -0.5),
        'rwkv_g_up': nrm((E, GATE_LORA, RWKV_DIM), GATE_LORA ** -0.5),
        'rwkv_k_k': 0.85 + nrm((E, RWKV_DIM), 0.02),
        'rwkv_k_a': 1.0 + nrm((E, RWKV_DIM), 0.02),
        'rwkv_r_k': nrm((E, RWKV_HEADS, RWKV_HEAD), 0.1),
        'rwkv_lnx_g': 1.0 + nrm((E, RWKV_DIM), 0.02),
        'rwkv_lnx_b': nrm((E, RWKV_DIM), 0.02),
        'att_q_norm': 1.0 + nrm((E, HEAD_DIM), 0.02),
        'att_k_norm': 1.0 + nrm((E, HEAD_DIM), 0.02),
        'hyb_w_out': nrm((E, D_MODEL, D_MODEL), D_MODEL ** -0.5),
        's5_lam_re_f': -0.5 + nrm((O, G, P), 0.01),
        's5_lam_im_f': jnp.pi * n_idx + nrm((O, G, P), 0.01),
        's5_log_dt_f': unif((O, G), float(np.log(1e-3)), float(np.log(1e-1))),
        's5_lam_re_b': -0.5 + nrm((O, G, P), 0.01),
        's5_lam_im_b': jnp.pi * n_idx + nrm((O, G, P), 0.01),
        's5_log_dt_b': unif((O, G), float(np.log(1e-3)), float(np.log(1e-1))),
        's5_b_re': nrm((O, G, P, GC), (2 * GC) ** -0.5),
        's5_b_im': nrm((O, G, P, GC), (2 * GC) ** -0.5),
        's5_c_re_f': nrm((O, G, GC, P), P ** -0.5),
        's5_c_im_f': nrm((O, G, GC, P), P ** -0.5),
        's5_c_re_b': nrm((O, G, GC, P), P ** -0.5),
        's5_c_im_b': nrm((O, G, GC, P), P ** -0.5),
        's5_d': nrm((O, D_MODEL), 1.0),
        's5_glu_w': nrm((O, D_MODEL, D_MODEL), D_MODEL ** -0.5),
        's5_glu_b': nrm((O, D_MODEL), 0.02),
    }


def reference(x_prompt, x_sample, mix_norm, ffn_norm, ffn_up, ffn_down, hyb_w_in, hyb_shift_mu,
              rwkv_w0_f, rwkv_w_up_f, rwkv_w0_b, rwkv_w_up_b, rwkv_a0, rwkv_a_up, rwkv_g_up,
              rwkv_k_k, rwkv_k_a, rwkv_r_k, rwkv_lnx_g, rwkv_lnx_b, att_q_norm, att_k_norm, hyb_w_out,
              s5_lam_re_f, s5_lam_im_f, s5_log_dt_f, s5_lam_re_b, s5_lam_im_b, s5_log_dt_b,
              s5_b_re, s5_b_im, s5_c_re_f, s5_c_im_f, s5_c_re_b, s5_c_im_b, s5_d, s5_glu_w, s5_glu_b):
    p = dict(mix_norm=mix_norm, ffn_norm=ffn_norm, ffn_up=ffn_up, ffn_down=ffn_down,
             hyb_w_in=hyb_w_in, hyb_shift_mu=hyb_shift_mu,
             rwkv_w0_f=rwkv_w0_f, rwkv_w_up_f=rwkv_w_up_f, rwkv_w0_b=rwkv_w0_b, rwkv_w_up_b=rwkv_w_up_b,
             rwkv_a0=rwkv_a0, rwkv_a_up=rwkv_a_up, rwkv_g_up=rwkv_g_up,
             rwkv_k_k=rwkv_k_k, rwkv_k_a=rwkv_k_a, rwkv_r_k=rwkv_r_k,
             rwkv_lnx_g=rwkv_lnx_g, rwkv_lnx_b=rwkv_lnx_b,
             att_q_norm=att_q_norm, att_k_norm=att_k_norm, hyb_w_out=hyb_w_out,
             s5_lam_re_f=s5_lam_re_f, s5_lam_im_f=s5_lam_im_f, s5_log_dt_f=s5_log_dt_f,
             s5_lam_re_b=s5_lam_re_b, s5_lam_im_b=s5_lam_im_b, s5_log_dt_b=s5_log_dt_b,
             s5_b_re=s5_b_re, s5_b_im=s5_b_im,
             s5_c_re_f=s5_c_re_f, s5_c_im_f=s5_c_im_f, s5_c_re_b=s5_c_re_b, s5_c_im_b=s5_c_im_b,
             s5_d=s5_d, s5_glu_w=s5_glu_w, s5_glu_b=s5_glu_b)
    y_prompt = _trunk(x_prompt, p)
    y_sample = _trunk(x_sample, p)
    return (y_prompt, y_sample)
```

```cpp
#include <hip/hip_runtime.h>
#include <hip/hip_cooperative_groups.h>
#include <cstdio>
#include <cstdint>
namespace cg = cooperative_groups;
namespace pg8 {
#define PG8_LAS __attribute__((address_space(3)))
typedef unsigned short bf16_t;
typedef short bf16x8 __attribute__((ext_vector_type(8)));
typedef float f32x4 __attribute__((ext_vector_type(4)));
typedef unsigned u32x4 __attribute__((ext_vector_type(4)));
constexpr int BM = 256, BK = 64, HALF = 128, HTB = HALF * BK * 2  , STAGE_BYTES = 8 * HTB, NXCD = 8, WGM = 8;

__host__ __device__ __forceinline__ int lds_byte(int r, int c) { const int st = (r >> 4) * 2 + (c >> 5), rr = r & 15, cc = c & 31, ob = rr * 64 + cc * 2; return st * 1024 + (ob ^ (((ob >> 9) & 1) << 5)); }
__host__ __device__ __forceinline__ void stage_rc(int b, int& R, int& C) { const int st = b / 1024, sb = b % 1024, swz = sb ^ (((sb >> 9) & 1) << 5); R = (st >> 1) * 16 + swz / 64; C = (st & 1) * 32 + (swz % 64) / 2; }
__host__ __device__ __forceinline__ int perm32(int rho) { const int n = rho >> 4, i = rho & 15; return 8 * (i >> 2) + 4 * n + (i & 3); }

struct Unit { int pm, pn; };
struct Gemm { const bf16_t* A; const bf16_t* Bt; int M, N, K, lda, kt, kmode; };

struct StaticOrder {
    int nM, nN, nwg, G, c;
    __host__ __device__ void init(int M, int N, int G_, int c_) { nM = M / BM; nN = N / BM; nwg = nM * nN; G = G_; c = c_; }
    __host__ __device__ bool next(int i, Unit& u) const {
        const long L = (long)i * G + c; if (L >= nwg) return false;
        int wgid = (int)L; { const int q = nwg / NXCD, r = nwg % NXCD, xcd = wgid % NXCD, off = wgid / NXCD; wgid = (xcd < r ? xcd * (q + 1) : r * (q + 1) + (xcd - r) * q) + off; }
        const int nig = WGM * nN, gid = wgid / nig, fm = gid * WGM, gsz = (nM - fm) < WGM ? (nM - fm) : WGM;
        u.pm = fm + ((wgid % nig) % gsz); u.pn = (wgid % nig) / gsz; return true;
    }
    __device__ __forceinline__ void a_ready(const Unit&) const {}
    __device__ __forceinline__ void done(const Unit&) const {}
};


__device__ __forceinline__ unsigned cvt_pk_bf16(float lo, float hi) { unsigned r; asm volatile("v_cvt_pk_bf16_f32 %0, %1, %2" : "=v"(r) : "v"(lo), "v"(hi)); return r; }
typedef float cvt_f32x2_t __attribute__((ext_vector_type(2))); typedef __bf16 cvt_bf16x2_t __attribute__((ext_vector_type(2)));
__device__ __forceinline__ unsigned cvt_pk_bf16_m(float lo, float hi) { cvt_f32x2_t v = {lo, hi}; cvt_bf16x2_t b = __builtin_convertvector(v, cvt_bf16x2_t); return __builtin_bit_cast(unsigned, b); }
__device__ __forceinline__ float fsigmoid(float x) { return __builtin_amdgcn_rcpf(1.0f + __expf(-x)); }
__device__ __forceinline__ u32x4 pack8(const f32x4 v0, const f32x4 v1) { u32x4 w; w.x = cvt_pk_bf16(v0[0], v0[1]); w.y = cvt_pk_bf16(v0[2], v0[3]); w.z = cvt_pk_bf16(v1[0], v1[1]); w.w = cvt_pk_bf16(v1[2], v1[3]); return w; }

struct EpiInProj {
    static constexpr bool PERM = true, AFTER_DRAIN = false;
    bf16_t* qkv; bf16_t* hr;
    __device__ __forceinline__ void operator()(const f32x4 (&acc)[2][2][4][2], const Unit& u, int wr, int wc, int fr, int fq) const {
        bf16_t* base; int ldc;
        if (u.pn < 3) { base = qkv + 512 + u.pn * 256; ldc = 1280; } else { base = hr + (u.pn - 3) * 256; ldc = 2048; }
        const int row0 = u.pm * BM + wr * 64 + fr, col0 = wc * 32 + 8 * fq;
#pragma unroll
        for (int ai = 0; ai < 2; ++ai)
#pragma unroll
            for (int m = 0; m < 4; ++m) { bf16_t* rowp = base + (size_t)(row0 + ai * HALF + m * 16) * ldc + col0;
#pragma unroll
                for (int bj = 0; bj < 2; ++bj) { const f32x4 v0 = acc[ai][bj][m][0], v1 = acc[ai][bj][m][1]; u32x4 w; w.x = cvt_pk_bf16_m(v0[0], v0[1]); w.y = cvt_pk_bf16_m(v0[2], v0[3]); w.z = cvt_pk_bf16_m(v1[0], v1[1]); w.w = cvt_pk_bf16_m(v1[2], v1[3]); *(u32x4*)(rowp + bj * HALF) = w; } }
    }
};
struct EpiUp {
    static constexpr bool PERM = true, AFTER_DRAIN = false;
    bf16_t* O;
    __device__ __forceinline__ void operator()(const f32x4 (&acc)[2][2][4][2], const Unit& u, int wr, int wc, int fr, int fq) const {
        const int row0 = u.pm * BM + wr * 64 + fr, col0 = u.pn * BM + wc * 32 + 8 * fq;
#pragma unroll
        for (int ai = 0; ai < 2; ++ai)
#pragma unroll
            for (int m = 0; m < 4; ++m) { bf16_t* rowp = O + (size_t)(row0 + ai * HALF + m * 16) * 4096 + col0;
#pragma unroll
                for (int bj = 0; bj < 2; ++bj) { f32x4 v0 = acc[ai][bj][m][0], v1 = acc[ai][bj][m][1];
#pragma unroll
                    for (int i = 0; i < 4; ++i) { const float a = fmaxf(v0[i], 0.f), b = fmaxf(v1[i], 0.f); v0[i] = a * a; v1[i] = b * b; }
                    *(u32x4*)(rowp + bj * HALF) = pack8(v0, v1); } }
    }
};
struct EpiLora {
    static constexpr bool PERM = true, AFTER_DRAIN = false;
    bf16_t* O; size_t stride; const float* bias;
    __device__ __forceinline__ void operator()(const f32x4 (&acc)[2][2][4][2], const Unit& u, int wr, int wc, int fr, int fq) const {
        const int which = u.pn >> 1;
        const int row0 = u.pm * BM + wr * 64 + fr, col0 = (u.pn & 1) * 256 + wc * 32 + 8 * fq;
        bf16_t* base = O + (size_t)which * stride + (size_t)row0 * 512 + col0;
        const float* bp = bias + which * 512 + col0;
        const float sc = (which < 2) ? 0.60653065971f : 1.0f;
#pragma unroll
        for (int bj = 0; bj < 2; ++bj) {
            const f32x4 b0 = *(const f32x4*)(bp + bj * HALF), b1 = *(const f32x4*)(bp + bj * HALF + 4);
#pragma unroll
            for (int ai = 0; ai < 2; ++ai)
#pragma unroll
                for (int m = 0; m < 4; ++m) { f32x4 v0 = acc[ai][bj][m][0] + b0, v1 = acc[ai][bj][m][1] + b1;
                    if (which < 3) {
#pragma unroll
                        for (int i = 0; i < 4; ++i) { v0[i] = sc * fsigmoid(v0[i]); v1[i] = sc * fsigmoid(v1[i]); } }
                    *(u32x4*)(base + (size_t)(ai * HALF + m * 16) * 512 + bj * HALF) = pack8(v0, v1);
                    asm volatile("" ::: "memory"); }
        }
    }
};
template <int MODE> struct EpiRes {
    static constexpr bool PERM = false, AFTER_DRAIN = false;
    const float* xp; const float* xs; float* out; const bf16_t* z; const float* bias;
    __device__ __forceinline__ void operator()(const f32x4 (&acc)[2][2][4][2], const Unit& u, int wr, int wc, int fr, int fq) const {
        const int col0 = u.pn * BM + wc * 32 + 4 * fq;
#pragma unroll
        for (int ai = 0; ai < 2; ++ai)
#pragma unroll
            for (int m = 0; m < 4; ++m) { const int r = u.pm * BM + ai * HALF + wr * 64 + m * 16 + fr; const size_t off = (size_t)r * 1024 + col0;
#pragma unroll
                for (int bj = 0; bj < 2; ++bj)
#pragma unroll
                    for (int n = 0; n < 2; ++n) { const size_t co = off + bj * HALF + n * 16; f32x4 o;
                        if (MODE == 0) { const float* src = (r < 16384) ? (xp + co) : (xs + (co - (size_t)16384 * 1024)); o = *(const f32x4*)src + acc[ai][bj][m][n]; }
                        else if (MODE == 1) { o = *(const f32x4*)(out + co) + acc[ai][bj][m][n]; }
                        else { const unsigned long long zz = *(const unsigned long long*)(z + co); const f32x4 bv = *(const f32x4*)(bias + col0 + bj * HALF + n * 16);
                            f32x4 zf; zf[0] = __uint_as_float((unsigned)(zz << 16) & 0xffff0000u); zf[1] = __uint_as_float((unsigned)zz & 0xffff0000u);
                            zf[2] = __uint_as_float((unsigned)(zz >> 16) & 0xffff0000u); zf[3] = __uint_as_float((unsigned)(zz >> 32) & 0xffff0000u);
                            const f32x4 a = acc[ai][bj][m][n] + bv; f32x4 sg;
#pragma unroll
                            for (int i = 0; i < 4; ++i) sg[i] = fsigmoid(a[i]);
                            o = *(const f32x4*)(out + co) + zf * sg; }
                        *(f32x4*)(out + co) = o; }
                asm volatile("" ::: "memory"); }
    }
};
__device__ __forceinline__ size_t gemm_koff(int kmode, int pn) { if (!kmode) return 0; const int which = pn >> 1; const int ks = which < 2 ? 0 : (which == 2 ? 2 : 3); return (size_t)ks * (BK * 2); }
template <class Epi, class Sched, bool ALIGN_EPI = false, bool SP2 = false>
__device__ __forceinline__ void gemm_phase(PG8_LAS unsigned char* lds, const Gemm g, const Sched& S, const Epi& E) {
    int tid_ = threadIdx.x; asm volatile("" : "+v"(tid_));
    const int tid = tid_, wid = __builtin_amdgcn_readfirstlane(tid >> 6), lane = tid & 63, wr = wid >> 2, wc = wid & 3, fr = lane & 15, fq = lane >> 4;
    const int K = g.K; int nt_ = K / BK; if (g.kt) { nt_ = g.kt; asm volatile("" : "+s"(nt_)); }
    const int nt = nt_;
    unsigned voffA[2], voffB[2];
#pragma unroll
    for (int i = 0; i < 2; ++i) { int R, C; stage_rc(tid * 16 + i * 8192, R, C); const int Rb = Epi::PERM ? ((R & ~31) + perm32(R & 31)) : R;
        voffA[i] = (unsigned)(R * g.lda + C) * 2u; voffB[i] = (unsigned)(Rb * K + C) * 2u; }
    const size_t kstep = (size_t)(BK * 2);
    const size_t hstepA = (size_t)HALF * g.lda * 2, hstepB = (size_t)HALF * K * 2;
    const size_t tstepA = 2 * hstepA, tstepB = 2 * hstepB;
    const unsigned ldsw = (unsigned)wid * 1024u;
    const int aoff = lds_byte(wr * 64 + fr, fq * 8), boff = lds_byte(wc * 32 + fr, fq * 8);
#define PG8_SA(b, h) (((b) * 2 + (h)) * HTB)
#define PG8_SB(b, h) ((4 + (b) * 2 + (h)) * HTB)
#define PG8_STAGE(bufoff, gbase, voff) do { _Pragma("unroll") for (int _i = 0; _i < 2; ++_i) \
        __builtin_amdgcn_global_load_lds((const unsigned*)((const char*)(gbase) + (voff)[_i]), (PG8_LAS unsigned*)(lds + (bufoff) + ldsw + _i * 8192), 16, 0, 0); } while (0)
#define PG8_LDA(dst, b, h) do { _Pragma("unroll") for (int m = 0; m < 4; ++m) _Pragma("unroll") for (int k = 0; k < 2; ++k) dst[m][k] = *(const PG8_LAS bf16x8*)(lds + PG8_SA(b, h) + aoff + m * 2048 + k * 1024); } while (0)
#define PG8_LDB(dst, b, h) do { _Pragma("unroll") for (int n = 0; n < 2; ++n) _Pragma("unroll") for (int k = 0; k < 2; ++k) dst[n][k] = *(const PG8_LAS bf16x8*)(lds + PG8_SB(b, h) + boff + n * 2048 + k * 1024); } while (0)
#define PG8_MMA(ai, bj, At, Bt) do { __builtin_amdgcn_s_setprio(1); _Pragma("unroll") for (int m = 0; m < 4; ++m) _Pragma("unroll") for (int n = 0; n < 2; ++n) _Pragma("unroll") for (int k = 0; k < 2; ++k) \
        acc[ai][bj][m][n] = __builtin_amdgcn_mfma_f32_16x16x32_bf16(Bt[n][k], At[m][k], acc[ai][bj][m][n], 0, 0, 0); __builtin_amdgcn_s_setprio(0); } while (0)
#define PG8_WAIT_V(n) asm volatile("s_waitcnt vmcnt(" #n ")" ::: "memory")
#define PG8_WAIT_L(n) asm volatile("s_waitcnt lgkmcnt(" #n ")" ::: "memory")
#define PG8_BAR __builtin_amdgcn_s_barrier()
#define PG8_SCHED __builtin_amdgcn_sched_barrier(0)
    Unit cur, nxt; int ui = 0;
    if (!S.next(0, cur)) return;
    f32x4 acc[2][2][4][2];
#pragma unroll
    for (int a = 0; a < 2; ++a)
#pragma unroll
        for (int b = 0; b < 2; ++b)
#pragma unroll
            for (int m = 0; m < 4; ++m)
#pragma unroll
                for (int n = 0; n < 2; ++n) acc[a][b][m][n] = (f32x4){0.f, 0.f, 0.f, 0.f};
    bf16x8 At[4][2], B0[2][2], B1[2][2];
    const char* cA = (const char*)g.A + (size_t)cur.pm * tstepA + gemm_koff(g.kmode, cur.pn); const char* cB = (const char*)g.Bt + (size_t)cur.pn * tstepB + gemm_koff(g.kmode, cur.pn);
    S.a_ready(cur);
    if constexpr (SP2) {
        PG8_STAGE(PG8_SB(0, 0), cB, voffB); PG8_STAGE(PG8_SB(0, 1), cB + hstepB, voffB); PG8_STAGE(PG8_SA(0, 0), cA, voffA); PG8_STAGE(PG8_SA(0, 1), cA + hstepA, voffA);
        if (wr == 1) PG8_BAR;
        PG8_WAIT_V(2); PG8_BAR;
        PG8_STAGE(PG8_SB(1, 0), cB + kstep, voffB); PG8_STAGE(PG8_SA(1, 0), cA + kstep, voffA); PG8_STAGE(PG8_SB(1, 1), cB + hstepB + kstep, voffB);
        PG8_WAIT_V(6); PG8_BAR;
    } else {
        PG8_STAGE(PG8_SB(0, 0), cB, voffB); PG8_STAGE(PG8_SA(0, 0), cA, voffA); PG8_STAGE(PG8_SB(0, 1), cB + hstepB, voffB); PG8_STAGE(PG8_SA(0, 1), cA + hstepA, voffA);
        if (wr == 1) PG8_BAR;
        PG8_WAIT_V(4); PG8_BAR;
        PG8_STAGE(PG8_SB(1, 0), cB + kstep, voffB); PG8_STAGE(PG8_SA(1, 0), cA + kstep, voffA); PG8_STAGE(PG8_SB(1, 1), cB + hstepB + kstep, voffB);
        PG8_WAIT_V(6); PG8_BAR;
    }
    for (;;) {
        const bool has_next = S.next(ui + 1, nxt);
        const char* nA = has_next ? (const char*)g.A + (size_t)nxt.pm * tstepA + gemm_koff(g.kmode, nxt.pn) : cA; const char* nB = has_next ? (const char*)g.Bt + (size_t)nxt.pn * tstepB + gemm_koff(g.kmode, nxt.pn) : cB;
#pragma unroll 1
        for (int t = 0; t < nt; t += 2) {
            const bool last = (t == nt - 2);
            const char* a1 = cA + (size_t)(t + 1) * kstep;
            const char* a2 = last ? nA : cA + (size_t)(t + 2) * kstep; const char* b2 = last ? nB : cB + (size_t)(t + 2) * kstep;
            const char* a3 = a2 + kstep; const char* b3 = b2 + kstep;
            if (last && has_next) S.a_ready(nxt);
            if constexpr (SP2) {
            PG8_LDB(B0, 0, 0); PG8_LDB(B1, 0, 1); PG8_SCHED; PG8_LDA(At, 0, 0); PG8_STAGE(PG8_SA(1, 1), a1 + hstepA, voffA);
            PG8_WAIT_V(8); PG8_WAIT_L(0); PG8_BAR; PG8_MMA(0, 0, At, B0); PG8_MMA(0, 1, At, B1); PG8_BAR; PG8_SCHED;
            PG8_LDA(At, 0, 1); PG8_STAGE(PG8_SB(0, 0), b2, voffB); PG8_STAGE(PG8_SB(0, 1), b2 + hstepB, voffB); PG8_STAGE(PG8_SA(0, 0), a2, voffA);
            PG8_WAIT_V(8); PG8_WAIT_L(0); PG8_BAR; PG8_MMA(1, 0, At, B0); PG8_MMA(1, 1, At, B1); PG8_BAR; PG8_SCHED;
            PG8_LDB(B0, 1, 0); PG8_LDB(B1, 1, 1); PG8_SCHED; PG8_LDA(At, 1, 0); PG8_STAGE(PG8_SA(0, 1), a2 + hstepA, voffA);
            PG8_WAIT_V(8); PG8_WAIT_L(0); PG8_BAR; PG8_MMA(0, 0, At, B0); PG8_MMA(0, 1, At, B1); PG8_BAR; PG8_SCHED;
            PG8_LDA(At, 1, 1); PG8_STAGE(PG8_SB(1, 0), b3, voffB); PG8_STAGE(PG8_SB(1, 1), b3 + hstepB, voffB); PG8_STAGE(PG8_SA(1, 0), a3, voffA);
            PG8_WAIT_V(8); PG8_WAIT_L(0); PG8_BAR; PG8_MMA(1, 0, At, B0); PG8_MMA(1, 1, At, B1); PG8_BAR; PG8_SCHED;
            } else {
            PG8_LDB(B0, 0, 0); PG8_SCHED; PG8_LDA(At, 0, 0); PG8_STAGE(PG8_SA(1, 1), a1 + hstepA, voffA);
            PG8_WAIT_L(8); PG8_BAR; PG8_WAIT_L(0); PG8_MMA(0, 0, At, B0); PG8_BAR; PG8_SCHED;
            PG8_LDB(B1, 0, 1); PG8_STAGE(PG8_SB(0, 0), b2, voffB);
            PG8_BAR; PG8_WAIT_L(0); PG8_MMA(0, 1, At, B1); PG8_BAR;
            PG8_LDA(At, 0, 1); PG8_STAGE(PG8_SA(0, 0), a2, voffA);
            PG8_BAR; PG8_WAIT_L(0); PG8_MMA(1, 0, At, B0); PG8_BAR; PG8_SCHED;
            PG8_STAGE(PG8_SB(0, 1), b2 + hstepB, voffB);
            PG8_WAIT_V(6); PG8_BAR; PG8_MMA(1, 1, At, B1); PG8_BAR;
            PG8_LDB(B0, 1, 0); PG8_SCHED; PG8_LDA(At, 1, 0); PG8_STAGE(PG8_SA(0, 1), a2 + hstepA, voffA);
            PG8_WAIT_L(8); PG8_BAR; PG8_WAIT_L(0); PG8_MMA(0, 0, At, B0); PG8_BAR; PG8_SCHED;
            PG8_LDB(B1, 1, 1); PG8_STAGE(PG8_SB(1, 0), b3, voffB);
            PG8_BAR; PG8_WAIT_L(0); PG8_MMA(0, 1, At, B1); PG8_BAR;
            PG8_LDA(At, 1, 1); PG8_STAGE(PG8_SA(1, 0), a3, voffA);
            PG8_BAR; PG8_WAIT_L(0); PG8_MMA(1, 0, At, B0); PG8_BAR; PG8_SCHED;
            PG8_STAGE(PG8_SB(1, 1), b3 + hstepB, voffB);
            PG8_WAIT_V(6); PG8_BAR; PG8_MMA(1, 1, At, B1); PG8_BAR;
            }
        }
        if constexpr (ALIGN_EPI) { if (wr == 0) PG8_BAR; }
        if constexpr (!Epi::AFTER_DRAIN) { E(acc, cur, wr, wc, fr, fq); S.done(cur); }
        if (!has_next) break;
#pragma unroll
        for (int a = 0; a < 2; ++a)
#pragma unroll
            for (int b = 0; b < 2; ++b)
#pragma unroll
                for (int m = 0; m < 4; ++m)
#pragma unroll
                    for (int n = 0; n < 2; ++n) acc[a][b][m][n] = (f32x4){0.f, 0.f, 0.f, 0.f};
        cur = nxt; cA = nA; cB = nB; ++ui;
        if constexpr (ALIGN_EPI) { if (wr == 1) PG8_BAR; }
    }
    PG8_WAIT_V(0);
    if constexpr (!ALIGN_EPI) { if (wr == 0) PG8_BAR; }
    PG8_BAR;
    if constexpr (Epi::AFTER_DRAIN) { E.fused(acc, cur, wr, wc, fr, fq, lds, wid, lane); S.done(cur); }
#undef PG8_SA
#undef PG8_SB
#undef PG8_STAGE
#undef PG8_LDA
#undef PG8_LDB
#undef PG8_MMA
#undef PG8_WAIT_V
#undef PG8_WAIT_L
#undef PG8_BAR
#undef PG8_SCHED
}
}
#include <hip/hip_bf16.h>
#include <cmath>
namespace attn_body {
using bf16=__hip_bfloat16;
using bf16x8=__attribute__((ext_vector_type(8)))short;
using s16x4=__attribute__((ext_vector_type(4)))short;
using f32x16=__attribute__((ext_vector_type(16)))float;
using u32x4=__attribute__((ext_vector_type(4)))unsigned;
constexpr int BATCH=6,NHEAD=8,SEQ=8192,D=64,DM=1280;
constexpr int NW=8,QBLK=32,QB=QBLK*NW,KVBLK=64,NQB=SEQ/QB;
constexpr int ATTN_PITCH=DM, ATTN_UNIT_ROWS=QB;
__device__ __forceinline__ int crow(int r,int hi){return (r&3)+8*(r>>2)+4*hi;}
#define SBAR() __builtin_amdgcn_sched_barrier(0)
constexpr int NSLOT=3, SLOTB=8192;
constexpr int LDS_K=0, LDS_V=NSLOT*SLOTB, LDS_WS=2*NSLOT*SLOTB, LDS_OST=LDS_WS+NW*64*4, LDS_BYTES=LDS_OST+NW*4096;
constexpr float C2=0.125f*1.4426950408889634f;
__device__ __forceinline__ void glds16(const void*gsrc,unsigned lds_dst){unsigned keep;
  asm volatile("s_mov_b32 %0, m0\n\ts_mov_b32 m0, %2\n\ts_nop 0\n\tglobal_load_lds_dwordx4 %1, off\n\ts_mov_b32 m0, %0":"=&s"(keep):"v"(gsrc),"s"(lds_dst):"memory");}
__device__ __forceinline__ float max3f(float a,float b,float c){float r;asm("v_max3_f32 %0, %1, %2, %3":"=v"(r):"v"(a),"v"(b),"v"(c));return r;}
__device__ __forceinline__ float max2f(float a,float b){float r;asm("v_max_f32_e32 %0, %1, %2":"=v"(r):"v"(a),"v"(b));return r;}
__device__ __forceinline__ float fadd_s(float a,float b){float r;asm("v_add_f32_e32 %0, %1, %2":"=v"(r):"v"(a),"v"(b));return r;}
__device__ __forceinline__ float fsub_s(float a,float b){float r;asm("v_sub_f32_e32 %0, %1, %2":"=v"(r):"v"(a),"v"(b));return r;}
typedef float f32x2_t __attribute__((ext_vector_type(2))); typedef __bf16 bf16x2_t __attribute__((ext_vector_type(2)));
__device__ __forceinline__ unsigned cvtpk_s(float lo,float hi){f32x2_t v={lo,hi};bf16x2_t b=__builtin_convertvector(v,bf16x2_t);return __builtin_bit_cast(unsigned,b);}
#define WAIT_BAR(N) asm volatile("s_waitcnt vmcnt(" #N ") lgkmcnt(0)\n\ts_barrier":::"memory")

__device__ __forceinline__ void qkt(f32x16&p0,f32x16&p1,const char*Kslot,const bf16x8*qr,const f32x16&negm,int r32,int hi){
  const char*kb=Kslot+hi*1024+r32*16;
  #pragma unroll
  for(int d0=0;d0<4;++d0){
    const bf16x8 b0=*reinterpret_cast<const bf16x8*>(kb+d0*2048);
    const bf16x8 b1=*reinterpret_cast<const bf16x8*>(kb+d0*2048+512);
    if(d0==0){p0=__builtin_amdgcn_mfma_f32_32x32x16_bf16(b0,qr[0],negm,0,0,0);p1=__builtin_amdgcn_mfma_f32_32x32x16_bf16(b1,qr[0],negm,0,0,0);}
    else{p0=__builtin_amdgcn_mfma_f32_32x32x16_bf16(b0,qr[d0],p0,0,0,0);p1=__builtin_amdgcn_mfma_f32_32x32x16_bf16(b1,qr[d0],p1,0,0,0);}}
}
typedef __attribute__((address_space(3))) const char* lds_cptr;
typedef short v4i16_t __attribute__((ext_vector_type(4)));
__device__ __forceinline__ void kload8(bf16x8*kf,lds_cptr kp){
  kf[0]=*(const __attribute__((address_space(3))) bf16x8*)(kp);      kf[1]=*(const __attribute__((address_space(3))) bf16x8*)(kp+512);
  kf[2]=*(const __attribute__((address_space(3))) bf16x8*)(kp+2048); kf[3]=*(const __attribute__((address_space(3))) bf16x8*)(kp+2560);
  kf[4]=*(const __attribute__((address_space(3))) bf16x8*)(kp+4096); kf[5]=*(const __attribute__((address_space(3))) bf16x8*)(kp+4608);
  kf[6]=*(const __attribute__((address_space(3))) bf16x8*)(kp+6144); kf[7]=*(const __attribute__((address_space(3))) bf16x8*)(kp+6656);
}
__device__ __forceinline__ void kload2(bf16x8*kf,lds_cptr kp,int j){ kf[2*j]=*(const __attribute__((address_space(3))) bf16x8*)(kp+j*2048); kf[2*j+1]=*(const __attribute__((address_space(3))) bf16x8*)(kp+j*2048+512); }
__device__ __forceinline__ s16x4 vtr(lds_cptr p){ return __builtin_bit_cast(s16x4,__builtin_amdgcn_ds_read_tr16_b64_v4i16((__attribute__((address_space(3))) v4i16_t*)p)); }
__device__ __forceinline__ float rowmax(const f32x16&p0,const f32x16&p1){
  float a=max3f(p0[0],p0[1],p1[0]),b=max3f(p0[2],p0[3],p1[1]);a=max3f(a,p1[2],p1[3]);
  #pragma unroll
  for(int r=4;r<16;r+=4){a=max3f(a,p0[r],p0[r+1]);b=max3f(b,p0[r+2],p0[r+3]);a=max3f(a,p1[r],p1[r+1]);b=max3f(b,p1[r+2],p1[r+3]);}
  const float m=max2f(a,b);
  auto rr=__builtin_amdgcn_permlane32_swap(__float_as_uint(m),__float_as_uint(m),false,false);
  return max2f(__uint_as_float(rr[0]),__uint_as_float(rr[1]));
}
__device__ __forceinline__ void pv(f32x16*o,int vb,bf16x8 pa0,bf16x8 pa1,bf16x8 pa2,bf16x8 pa3){
  #pragma unroll
  for(int d0=0;d0<2;++d0){s16x4 lo[4],hi[4];
    #pragma unroll
    for(int ks=0;ks<4;++ks){
      asm volatile("ds_read_b64_tr_b16 %0,%1 offset:%c2":"=&v"(lo[ks]):"v"(vb),"i"(d0*4096+ks*1024):"memory");
      asm volatile("ds_read_b64_tr_b16 %0,%1 offset:%c2":"=&v"(hi[ks]):"v"(vb),"i"(d0*4096+ks*1024+512):"memory");}
    asm volatile("s_waitcnt lgkmcnt(0)":::"memory");SBAR();
    #define PK(k) (bf16x8){lo[k][0],lo[k][1],lo[k][2],lo[k][3],hi[k][0],hi[k][1],hi[k][2],hi[k][3]}
    o[d0]=__builtin_amdgcn_mfma_f32_32x32x16_bf16(pa0,PK(0),o[d0],0,0,0);
    o[d0]=__builtin_amdgcn_mfma_f32_32x32x16_bf16(pa1,PK(1),o[d0],0,0,0);
    o[d0]=__builtin_amdgcn_mfma_f32_32x32x16_bf16(pa2,PK(2),o[d0],0,0,0);
    o[d0]=__builtin_amdgcn_mfma_f32_32x32x16_bf16(pa3,PK(3),o[d0],0,0,0);
    #undef PK
  }
}

#ifndef ATTN_STORE16
#define ATTN_STORE16(p,v) (*(u32x4*)(p)=(v))
#endif
template<int THRL> __device__ __forceinline__ void attn_unit(int b,int h,int qb,const bf16*Q,const bf16*__restrict__ K,const bf16*__restrict__ V,bf16*O,char*shm){
  int tid_=threadIdx.x; asm volatile("":"+v"(tid_)); const int tid=tid_,lane=tid&63,r32=lane&31,hi=lane>>5; const int wid=__builtin_amdgcn_readfirstlane(tid>>6);
  const long rowbase=(long)b*SEQ; const int q0=qb*QB;
  const bf16*Qw=Q+(rowbase+q0+wid*QBLK)*DM+h*D;
  const bf16*Kh=K+rowbase*DM+(h>>2)*D,*Vh=V+rowbase*DM+(h>>2)*D;
  const unsigned lds0=(unsigned)(uintptr_t)shm;
  float*wsf=(float*)(shm+LDS_WS)+wid*64;
  const bf16*ksrc=Kh+(long)lane*DM+wid*8;
  const bf16*vsrc=Vh+(long)(16*(wid&3)+(lane>>2))*DM+(wid>>2)*32+(lane&3)*8;
  const unsigned kdst=lds0+LDS_K+wid*1024, vdst=lds0+LDS_V+wid*1024;
  #define DMA_K(t,slot) glds16(ksrc+(long)(t)*KVBLK*DM,(unsigned)__builtin_amdgcn_readfirstlane(kdst+(slot)))
  #define DMA_V(t,slot) glds16(vsrc+(long)(t)*KVBLK*DM,(unsigned)__builtin_amdgcn_readfirstlane(vdst+(slot)))
  const int vb0=(int)(lds0+LDS_V)+((lane>>4)&1)*32+(lane&3)*8+(4*hi+((lane&15)>>2))*64;
  const char*Kbase=shm+LDS_K; bf16x8 kf[8];
  const lds_cptr shm3=(lds_cptr)shm; const lds_cptr kp0=shm3+LDS_K+hi*1024+r32*16; const lds_cptr vp0=shm3+LDS_V+((lane>>4)&1)*32+(lane&3)*8+(4*hi+((lane&15)>>2))*64;
  constexpr int NT=SEQ/KVBLK;
  DMA_K(0,0);DMA_V(0,0);DMA_K(1,SLOTB);
  bf16x8 qr[4];
  #pragma unroll
  for(int d0=0;d0<4;++d0)qr[d0]=*reinterpret_cast<const bf16x8*>(&Qw[(long)r32*DM+d0*16+hi*8]);
  float mhat=0.f,l_reg=0.f;f32x16 o[2];o[0]=f32x16{};o[1]=f32x16{};f32x16 negm=f32x16{};asm volatile("":"+v"(negm));
  const int qrel=wid*QBLK+r32;
  #define CMASK(P0,P1,t) do{}while(0)
  bool resc=false;
  #define START(P0,P1) do{ resc=false; \
    _Pragma("unroll") for(int r=0;r<16;++r)P0[r]=__builtin_amdgcn_exp2f(P0[r]); }while(0)
  #define RESC() do{ if(resc){ asm volatile("s_waitcnt lgkmcnt(0)":::"memory"); \
      _Pragma("unroll") for(int d_=0;d_<2;++d_) _Pragma("unroll") for(int r=0;r<16;++r)o[d_][r]*=wsf[crow(r,hi)]; } }while(0)
  f32x16 pA0,pA1,pB0,pB1;
  int sl_prev=0,sl_cur=0,sl_next=SLOTB;
  #define ROT() do{sl_prev=sl_cur;sl_cur=sl_next;sl_next=(sl_next==(NSLOT-1)*SLOTB)?0:sl_next+SLOTB;}while(0)
  DMA_K(2,2*SLOTB);
  WAIT_BAR(3);
  qkt(pA0,pA1,Kbase,qr,negm,r32,hi);asm volatile("s_nop 15\n\ts_nop 7":"+v"(pA0),"+v"(pA1));CMASK(pA0,pA1,0);
  START(pA0,pA1);
  _Pragma("unroll") for(int r=0;r<16;++r)pA1[r]=__builtin_amdgcn_exp2f(pA1[r]);
  WAIT_BAR(0);
  DMA_K(3,0);DMA_V(1,SLOTB);
  ROT();
  kload8(kf,kp0+sl_cur);
  WAIT_BAR(2);
  s16x4 vlo[8],vhi[8]; u32x4 pw0,pw1,pw2,pw3;
  #define PKW(P,B) cvtpk_s(P[B],P[B+1])
  #define PAF(k) __builtin_bit_cast(bf16x8,pw##k)
  #define VFR(i) (bf16x8){vlo[i][0],vlo[i][1],vlo[i][2],vlo[i][3],vhi[i][0],vhi[i][1],vhi[i][2],vhi[i][3]}
  #define PIN(x) asm volatile("":"+v"(x))
  #define MX3(a,b,c) __builtin_fmaxf(__builtin_fmaxf((a),(b)),(c))
  #define GAPA(MF,A0,A1,A2,A3,W0,W1,PW) do{ MF; sacc+=A0; sacc+=A1; sacc+=A2; sacc+=A3; PIN(sacc); W0; W1; PIN(PW); SBAR(); }while(0)
  #define EX(v) __builtin_amdgcn_exp2f(v)
  #define GAPB(MF,X,B) do{ MF; X[B]=EX(X[B]); X[B+1]=EX(X[B+1]); X[B+2]=EX(X[B+2]); X[B+3]=EX(X[B+3]); PIN(X); SBAR(); }while(0)
  #define VRD(i) do{ vlo[i]=vtr(vp_+(((i)>>2)*4096+((i)&3)*1024)); vhi[i]=vtr(vp_+(((i)>>2)*4096+((i)&3)*1024+512)); }while(0)
  #define KRD(G,j) do{ if(G){ kload2(kf,kp0+sl_next,j); SBAR(); } }while(0)
  #define STEP(C0,C1,P0,P1,t,GK,GV,GL) do{ SBAR(); \
    const lds_cptr vp_=vp0+sl_prev; \
    VRD(0); SBAR(); float sacc=(P0[0]+P0[1]); \
    GAPA(C0=__builtin_amdgcn_mfma_f32_32x32x16_bf16(kf[0],qr[0],negm,0,0,0), P0[2],P0[3],P0[4],P0[5],     pw0[0]=PKW(P0,0), pw0[1]=PKW(P0,2), pw0); \
    VRD(4); SBAR(); GAPA(C1=__builtin_amdgcn_mfma_f32_32x32x16_bf16(kf[1],qr[0],negm,0,0,0), P0[6],P0[7],P0[8],P0[9],     pw0[2]=PKW(P0,4), pw0[3]=PKW(P0,6), pw0); \
    VRD(1); SBAR(); GAPA(C0=__builtin_amdgcn_mfma_f32_32x32x16_bf16(kf[2],qr[1],C0,0,0,0),   P0[10],P0[11],P0[12],P0[13], pw1[0]=PKW(P0,8), pw1[1]=PKW(P0,10), pw1); \
    VRD(5); SBAR(); GAPA(C1=__builtin_amdgcn_mfma_f32_32x32x16_bf16(kf[3],qr[1],C1,0,0,0),   P0[14],P0[15],P1[0],P1[1],   pw1[2]=PKW(P0,12),pw1[3]=PKW(P0,14), pw1); \
    VRD(2); SBAR(); GAPA(C0=__builtin_amdgcn_mfma_f32_32x32x16_bf16(kf[4],qr[2],C0,0,0,0),   P1[2],P1[3],P1[4],P1[5],     pw2[0]=PKW(P1,0), pw2[1]=PKW(P1,2), pw2); \
    VRD(6); SBAR(); GAPA(C1=__builtin_amdgcn_mfma_f32_32x32x16_bf16(kf[5],qr[2],C1,0,0,0),   P1[6],P1[7],P1[8],P1[9],     pw2[2]=PKW(P1,4), pw2[3]=PKW(P1,6), pw2); \
    VRD(3); SBAR(); GAPA(C0=__builtin_amdgcn_mfma_f32_32x32x16_bf16(kf[6],qr[3],C0,0,0,0),   P1[10],P1[11],P1[12],P1[13], pw3[0]=PKW(P1,8), pw3[1]=PKW(P1,10), pw3); \
    VRD(7); SBAR(); GAPA(C1=__builtin_amdgcn_mfma_f32_32x32x16_bf16(kf[7],qr[3],C1,0,0,0),   P1[14],P1[15],0.f,0.f,       pw3[2]=PKW(P1,12),pw3[3]=PKW(P1,14), pw3); \
    l_reg+=sacc; \
    if(GK){DMA_K((t)+3,sl_cur);} if(GV){DMA_V((t)+1,sl_next);} \
    CMASK(C0,C1,t); \
    resc=false; \
    SBAR(); \
    GAPB(o[0]=__builtin_amdgcn_mfma_f32_32x32x16_bf16(PAF(0),VFR(0),o[0],0,0,0), C0,0); \
    GAPB(o[1]=__builtin_amdgcn_mfma_f32_32x32x16_bf16(PAF(0),VFR(4),o[1],0,0,0), C0,4); \
    KRD(GL,0); GAPB(o[0]=__builtin_amdgcn_mfma_f32_32x32x16_bf16(PAF(1),VFR(1),o[0],0,0,0), C0,8); \
    KRD(GL,1); GAPB(o[1]=__builtin_amdgcn_mfma_f32_32x32x16_bf16(PAF(1),VFR(5),o[1],0,0,0), C0,12); \
    KRD(GL,2); GAPB(o[0]=__builtin_amdgcn_mfma_f32_32x32x16_bf16(PAF(2),VFR(2),o[0],0,0,0), C1,0); \
    KRD(GL,3); GAPB(o[1]=__builtin_amdgcn_mfma_f32_32x32x16_bf16(PAF(2),VFR(6),o[1],0,0,0), C1,4); \
    GAPB(o[0]=__builtin_amdgcn_mfma_f32_32x32x16_bf16(PAF(3),VFR(3),o[0],0,0,0), C1,8); \
    GAPB(o[1]=__builtin_amdgcn_mfma_f32_32x32x16_bf16(PAF(3),VFR(7),o[1],0,0,0), C1,12); \
    }while(0)
  int t=1;
  #undef CMASK
  #define CMASK(P0,P1,t) do{}while(0)
  for(;t+5<NT;t+=2){
    STEP(pB0,pB1,pA0,pA1,t,true,true,true);     WAIT_BAR(2); RESC(); ROT();
    STEP(pA0,pA1,pB0,pB1,t+1,true,true,true);   WAIT_BAR(2); RESC(); ROT();
  }
  #undef CMASK
  #define CMASK(P0,P1,t) do{}while(0)
  #define ENDW(tt) do{ if((tt)+3<NT){WAIT_BAR(2);} else if((tt)+2<NT){WAIT_BAR(1);} else {WAIT_BAR(0);} }while(0)
  for(;t+1<NT;t+=2){
    STEP(pB0,pB1,pA0,pA1,t,(t+3<NT),(t+1<NT),(t+1<NT));       ENDW(t);   RESC(); ROT();
    STEP(pA0,pA1,pB0,pB1,t+1,(t+4<NT),(t+2<NT),(t+2<NT));     ENDW(t+1); RESC(); ROT();
  }
  STEP(pB0,pB1,pA0,pA1,NT-1,false,false,false); RESC();
  { float sacc=pB0[0]+pB0[1]; _Pragma("unroll") for(int r=2;r<16;++r)sacc+=pB0[r]; _Pragma("unroll") for(int r=0;r<16;++r)sacc+=pB1[r]; l_reg+=sacc;
    pw0=(u32x4){PKW(pB0,0),PKW(pB0,2),PKW(pB0,4),PKW(pB0,6)};pw1=(u32x4){PKW(pB0,8),PKW(pB0,10),PKW(pB0,12),PKW(pB0,14)};pw2=(u32x4){PKW(pB1,0),PKW(pB1,2),PKW(pB1,4),PKW(pB1,6)};pw3=(u32x4){PKW(pB1,8),PKW(pB1,10),PKW(pB1,12),PKW(pB1,14)};
    SBAR(); pv(o,vb0+sl_cur,PAF(0),PAF(1),PAF(2),PAF(3)); }
  #undef PKW
  #undef PAF
  #undef VFR
  #undef PIN
  #undef MX3
  #undef GAPA
  #undef GAPB
  #undef EX
  #undef VRD
  #undef KRD
  #undef STEP
  #undef ENDW
  {auto rr=__builtin_amdgcn_permlane32_swap(__float_as_uint(l_reg),__float_as_uint(l_reg),false,false);l_reg=__uint_as_float(rr[0])+__uint_as_float(rr[1]);}
  if(hi==0)wsf[32+r32]=l_reg;asm volatile("s_waitcnt lgkmcnt(0)":::"memory");
  float rli[16];
  #pragma unroll
  for(int r=0;r<16;++r)rli[r]=__builtin_amdgcn_rcpf(wsf[32+crow(r,hi)]);
  bf16*Ow=O+(rowbase+q0+wid*QBLK)*DM+h*D;
  { bf16*stg=(bf16*)(shm+LDS_OST)+wid*2048;
    #pragma unroll
    for(int r=0;r<16;++r){const int orow=crow(r,hi);
      #pragma unroll
      for(int d0=0;d0<2;++d0)stg[orow*64+d0*32+r32]=__float2bfloat16(o[d0][r]*rli[r]);}
    asm volatile("s_waitcnt lgkmcnt(0)":::"memory");
    #pragma unroll
    for(int i=0;i<4;++i){const int row=i*8+(lane>>3),ch=lane&7; const u32x4 v=*(const u32x4*)(stg+row*64+ch*8); ATTN_STORE16(Ow+(long)row*DM+ch*8,v);} }
  asm volatile("s_waitcnt lgkmcnt(0)\n\ts_barrier":::"memory");
  #undef DMA_K
  #undef DMA_V
  #undef CMASK
  #undef START
  #undef RESC
  #undef ROT
}
constexpr int ATTN_LDS_BYTES=LDS_BYTES;
#undef SBAR
#undef WAIT_BAR
}
#define GAS __attribute__((address_space(1)))
#define LAS __attribute__((address_space(3)))
typedef unsigned short bf16;
typedef unsigned v4u __attribute__((ext_vector_type(4)));
typedef unsigned v2u __attribute__((ext_vector_type(2)));
typedef float f32x4 __attribute__((ext_vector_type(4)));
typedef float f32x2 __attribute__((ext_vector_type(2)));
typedef short bf16x8 __attribute__((ext_vector_type(8)));
constexpr int NWAVES = 8, NTHREADS = 512;
constexpr int NB = 6, T = 8192, D = 1024, FF = 4096, M = NB * T;
constexpr int MPROMPT = 2 * T;
constexpr size_t MiB = 1u << 20;
constexpr size_t WS_WIN = 1 * MiB, WS_WOUT = 7 * MiB, WS_WGLU = 9 * MiB, WS_WUP = 11 * MiB, WS_WDN = 19 * MiB, WS_WLORA = 27 * MiB, WS_LBIAS = 28 * MiB + 512 * 1024;
constexpr size_t WS_XN = 29 * MiB, WS_HID = 125 * MiB, WS_END = 509 * MiB;
constexpr size_t WS_R = 29 * MiB, WS_K = 77 * MiB, WS_QKV = 125 * MiB, WS_V = 245 * MiB, WS_YF = 293 * MiB, WS_YB = 341 * MiB, WS_A2 = 389 * MiB;
constexpr size_t WS_E = 125 * MiB, WS_CIN = 173 * MiB, WS_Z = 221 * MiB;
constexpr int LDS_BYTES = 147456, LDS_QWORD = 147392;
constexpr size_t WS_CTL = 0, WS_BAR = 65536;
constexpr int LDS_BARST = 147400;
constexpr size_t WS_ROWSQ = 262144;
constexpr int NIN = 2816, NLORA = 2048, KLORA = 384;

__device__ __forceinline__ float bf_lo(unsigned w) { return __uint_as_float(w << 16); }
__device__ __forceinline__ float bf_hi(unsigned w) { return __uint_as_float(w & 0xffff0000u); }
__device__ __forceinline__ float bf1(bf16 b) { return __uint_as_float((unsigned)b << 16); }
__device__ __forceinline__ unsigned pk2(float lo, float hi) { return pg8::cvt_pk_bf16(lo, hi); }
__device__ __forceinline__ void unpack8(const v4u w, float* f) { f[0] = bf_lo(w.x); f[1] = bf_hi(w.x); f[2] = bf_lo(w.y); f[3] = bf_hi(w.y); f[4] = bf_lo(w.z); f[5] = bf_hi(w.z); f[6] = bf_lo(w.w); f[7] = bf_hi(w.w); }
__device__ __forceinline__ v4u pack8f(const float* f) { v4u w; w.x = pk2(f[0], f[1]); w.y = pk2(f[2], f[3]); w.z = pk2(f[4], f[5]); w.w = pk2(f[6], f[7]); return w; }
__device__ __forceinline__ float fsig(float x) { return __builtin_amdgcn_rcpf(1.0f + __expf(-x)); }
__device__ __forceinline__ float ftanh(float x) { return 1.0f - 2.0f * __builtin_amdgcn_rcpf(1.0f + __expf(2.0f * x)); }
#define LDS_WAIT() asm volatile("s_waitcnt lgkmcnt(0)" ::: "memory")
template <int CTRL> __device__ __forceinline__ float dppf(float v) { return __builtin_bit_cast(float, __builtin_amdgcn_update_dpp(0, __builtin_bit_cast(int, v), CTRL, 0xF, 0xF, true)); }
__device__ __forceinline__ float sum16(float v) { v += dppf<0xB1>(v); v += dppf<0x4E>(v); v += dppf<0x124>(v); v += dppf<0x128>(v); return v; }
__device__ __forceinline__ float sum8(float v) { v += dppf<0xB1>(v); v += dppf<0x4E>(v); v += dppf<0x141>(v); return v; }

#define RLX_AGENT __ATOMIC_RELAXED, __HIP_MEMORY_SCOPE_AGENT
#define XB_TMO      128
#define XB_XCNT(j)  (256  + 64 * (j))
#define XB_XSUB(j)  (1280 + 64 * (j))
#define XB_XGEN(j)  (2304 + 64 * (j))
#define XB_TOP      3328
#define XB_TOPGEN   3392
#define XCD_BAR_WORDS 3456
#define XB_SPIN_CAP (1u << 18)

__device__ __forceinline__ unsigned xb_ld(unsigned* p)              { return __hip_atomic_load(p, __ATOMIC_RELAXED, __HIP_MEMORY_SCOPE_AGENT); }
__device__ __forceinline__ unsigned xb_add(unsigned* p, unsigned v) { return __hip_atomic_fetch_add(p, v, __ATOMIC_RELAXED, __HIP_MEMORY_SCOPE_AGENT); }
__device__ __forceinline__ unsigned xb_xcc_id() { return (unsigned)__builtin_amdgcn_s_getreg((3 << 11) | 20) & 0xFu; }
#define XB_SPIN(cond, bar) do { unsigned _sp = 0; while (cond) { __builtin_amdgcn_s_sleep(1); \
    if ((++_sp & 255u) == 0u) { if (xb_ld(&(bar)[XB_TMO])) break; if (_sp > XB_SPIN_CAP) { atomicAdd(&(bar)[XB_TMO], 1u); break; } } } } while (0)

struct XcdBarrier {
    unsigned* bar; unsigned x;
    volatile LAS unsigned* st;
};

__device__ __forceinline__ XcdBarrier xcd_barrier_post(unsigned* bar, volatile LAS unsigned* st) {
    XcdBarrier b; b.bar = bar; b.x = xb_xcc_id(); b.st = st;
    if (threadIdx.x == 0) (void)xb_add(&bar[XB_XCNT(b.x)], 1u);
    return b;
}
__device__ __forceinline__ void xcd_barrier_complete(unsigned* bar, unsigned x, unsigned& nloc, unsigned& nx) {
    const unsigned G = gridDim.x * gridDim.y * gridDim.z;
    unsigned sum, cnt, mine, sp = 0u;
    for (;;) {
        sum = 0u; cnt = 0u; mine = 0u;
#pragma unroll
        for (unsigned j = 0; j < 16; ++j) { const unsigned c = xb_ld(&bar[XB_XCNT(j)]); sum += c; cnt += (c > 0u) ? 1u : 0u; mine = (j == x) ? c : mine; }
        if (sum == G) break;
        __builtin_amdgcn_s_sleep(1);
        if ((++sp & 255u) == 0u) { if (xb_ld(&bar[XB_TMO])) break; if (sp > XB_SPIN_CAP) { atomicAdd(&bar[XB_TMO], 1u); break; } }
    }
    nloc = mine > 0u ? mine : 1u; nx = cnt > 0u ? cnt : 1u;
}

__device__ __forceinline__ void xcd_barrier(const XcdBarrier& b) {
    asm volatile("s_waitcnt vmcnt(0)" ::: "memory");
    __syncthreads();
    if (threadIdx.x == 0) {
        unsigned* bar = b.bar;
        __builtin_amdgcn_s_waitcnt(0);
        unsigned nloc = b.st[0], nx = b.st[1];
        if (nloc == 0u) { xcd_barrier_complete(bar, b.x, nloc, nx); b.st[0] = nloc; b.st[1] = nx; }
        const unsigned old = xb_add(&bar[XB_XSUB(b.x)], 1u);
        const unsigned gen = old / nloc;
        if (old + 1u == (gen + 1u) * nloc) {
            __builtin_amdgcn_fence(__ATOMIC_RELEASE, "agent");
            asm volatile("s_waitcnt vmcnt(0)" ::: "memory");
            const unsigned og = xb_add(&bar[XB_TOP], 1u);
            const unsigned tg = og / nx;
            if (og + 1u == (tg + 1u) * nx) xb_add(&bar[XB_TOPGEN], 1u);
            else XB_SPIN(xb_ld(&bar[XB_TOPGEN]) == tg, bar);
            __builtin_amdgcn_fence(__ATOMIC_ACQUIRE, "agent");
            xb_add(&bar[XB_XGEN(b.x)], 1u);
            asm volatile("s_waitcnt vmcnt(0)" ::: "memory");
        } else {
            XB_SPIN(xb_ld(&bar[XB_XGEN(b.x)]) == gen, bar);
            __builtin_amdgcn_fence(__ATOMIC_ACQUIRE, "agent");
            asm volatile("s_waitcnt vmcnt(0)" ::: "memory");
        }
    }
    __syncthreads();
}


struct Args { const float* in[38]; float* out; unsigned char* ws; int pad0, pad1; };

__device__ __forceinline__ void transpose_item(const float* W, int N, bf16* WT, int ldt, int k0, int n0, int drow0, LAS float* scr, int lane, const float* gain = nullptr) {
#pragma unroll 8
    for (int i = 0; i < 32; ++i) { const int kk = 2 * i + (lane >> 5); float wv = W[(size_t)(k0 + kk) * N + n0 + (lane & 31)]; if (gain) wv *= gain[k0 + kk]; scr[kk * 33 + (lane & 31)] = wv; }
    LDS_WAIT();
    const int c = lane & 7;
#pragma unroll
    for (int j = 0; j < 4; ++j) { const int n = (lane >> 3) + 8 * j; const LAS float* s = scr + (8 * c) * 33 + n;
        v4u o; o.x = pk2(s[0 * 33], s[1 * 33]); o.y = pk2(s[2 * 33], s[3 * 33]); o.z = pk2(s[4 * 33], s[5 * 33]); o.w = pk2(s[6 * 33], s[7 * 33]);
        *(v4u*)(WT + (size_t)(drow0 + n) * ldt + k0 + 8 * c) = o; }
    LDS_WAIT();
}
__device__ __forceinline__ void transpose_matrix(const float* W, int K, int N, bf16* WT, LAS float* scr, int gw, int NGW, int lane, const float* gain = nullptr) {
    const int nblk = N / 32, nit = (K / 64) * nblk;
    for (int it = gw; it < nit; it += NGW) { const int kb = it / nblk, nb = it % nblk; transpose_item(W, N, WT, K, 64 * kb, 32 * nb, 32 * nb, scr, lane, gain); }
}
__device__ __forceinline__ float wave_sum(float v) {
#pragma unroll
    for (int o = 1; o < 64; o <<= 1) v += __shfl_xor(v, o);
    return v;
}
template <int R>
__device__ __forceinline__ void rms_rows(const float* const (&xrow)[R], const float* gain, bf16* const (&orow)[R], int lane) {
    f32x4 v[R][4]; float s[R];
#pragma unroll
    for (int r = 0; r < R; ++r) { const f32x4* xr = (const f32x4*)xrow[r] + lane;
#pragma unroll
        for (int j = 0; j < 4; ++j) v[r][j] = xr[64 * j]; }
    const f32x4* gr = (const f32x4*)gain + lane;
    f32x4 g[4];
#pragma unroll
    for (int j = 0; j < 4; ++j) g[j] = gr[64 * j];
    asm volatile("s_waitcnt vmcnt(0)" ::: "memory");
#pragma unroll
    for (int r = 0; r < R; ++r) { s[r] = 0.f;
#pragma unroll
        for (int j = 0; j < 4; ++j) s[r] += (v[r][j].x * v[r][j].x + v[r][j].y * v[r][j].y) + (v[r][j].z * v[r][j].z + v[r][j].w * v[r][j].w); }
#pragma unroll
    for (int o = 1; o < 64; o <<= 1) {
#pragma unroll
        for (int r = 0; r < R; ++r) s[r] += __shfl_xor(s[r], o); }
#pragma unroll
    for (int r = 0; r < R; ++r) { const float rs = 1.0f / sqrtf(s[r] * (1.f / 1024.f) + 1e-6f); v2u* o8 = (v2u*)orow[r] + lane;
#pragma unroll
        for (int j = 0; j < 4; ++j) { v2u w; w.x = pk2(v[r][j].x * rs * g[j].x, v[r][j].y * rs * g[j].y); w.y = pk2(v[r][j].z * rs * g[j].z, v[r][j].w * rs * g[j].w); o8[64 * j] = w; } }
}
__device__ __forceinline__ void rms_all(const float* xa, const float* xb, int split, const float* gain, bf16* XN, int gw, int NGW, int lane) {
    for (int m0 = gw * 4; m0 < M; m0 += NGW * 4) { const float* xr[4]; bf16* orow[4];
#pragma unroll
        for (int r = 0; r < 4; ++r) { const int m = m0 + r; xr[r] = (m < split) ? xa + (size_t)m * D : xb + (size_t)(m - split) * D; orow[r] = XN + (size_t)m * D; }
        rms_rows<4>(xr, gain, orow, lane); }
}
__device__ __forceinline__ void phase_shift_qk(const Args& a, int gw, int NGW, int lane) {
    const bf16* HR = (const bf16*)a.out;
    bf16* Rb = (bf16*)(a.ws + WS_R); bf16* Kb = (bf16*)(a.ws + WS_K); bf16* Vb = (bf16*)(a.ws + WS_V); bf16* A2 = (bf16*)(a.ws + WS_A2);
    bf16* QKV = (bf16*)(a.ws + WS_QKV);
    const float* mu = a.in[7]; const float* qn = a.in[20]; const float* kn = a.in[21];
    const int p = lane & 31, half = lane >> 5;
    const float invf = exp2f(-(float)(p & 15) * (13.287712379549449f / 16.0f)) * 0.15915494309189535f;
    const float gq0 = qn[2 * p], gq1 = qn[2 * p + 1], gk0 = kn[2 * p], gk1 = kn[2 * p + 1];
    for (int tok = gw; tok < M; tok += NGW) {
        const int t = tok & (T - 1);
        const bf16* hrow = HR + (size_t)tok * 2048;
        v4u cc[4], pp[4], nn[4]; unsigned qw5[5];
        bf16* qrow = QKV + (size_t)tok * 1280 + 512;
#pragma unroll
        for (int i = 0; i < 4; ++i) { const int cgp = lane + 64 * i; cc[i] = (v4u){0u, 0u, 0u, 0u}; pp[i] = cc[i]; nn[i] = cc[i];
            if (cgp < 232) { const int col = cgp * 8; cc[i] = *(const v4u*)(hrow + col); if (t > 0) pp[i] = *(const v4u*)(hrow - 2048 + col); if (t < T - 1) nn[i] = *(const v4u*)(hrow + 2048 + col); } }
#pragma unroll
        for (int i = 0; i < 5; ++i) qw5[i] = *(const unsigned*)(qrow + (half + 2 * i) * 64 + 2 * p);
        asm volatile("s_waitcnt vmcnt(0)" ::: "memory");
#pragma unroll
        for (int i = 0; i < 4; ++i) { const int cgp = lane + 64 * i;
            if (cgp < 232) { const int col = cgp * 8;
                const v4u c = cc[i], pv = pp[i], nv = nn[i];
                const f32x4 m0 = *(const f32x4*)(mu + col), m1 = *(const f32x4*)(mu + col + 4);
                float h[8], pf[8], nf[8], hs[8]; unpack8(c, h); unpack8(pv, pf); unpack8(nv, nf);
#pragma unroll
                for (int j = 0; j < 8; ++j) { const float mj = j < 4 ? m0[j] : m1[j - 4]; hs[j] = h[j] + mj * (0.5f * (pf[j] + nf[j]) - h[j]); }
                if (col < 1536) { bf16* dst = (col < 512 ? Rb : (col < 1024 ? Kb : Vb)) + (size_t)tok * 512 + (col & 511); *(v4u*)dst = pack8f(hs); }
                else { const int c2 = col - 1536;
                    if (c2 < 128) {
#pragma unroll
                        for (int j = 0; j < 8; ++j) hs[j] = ftanh(hs[j]); }
                    else if (c2 >= 192) {
#pragma unroll
                        for (int j = 0; j < 8; ++j) hs[j] = fsig(hs[j]); }
                    *(v4u*)(A2 + (size_t)tok * KLORA + c2) = pack8f(hs); } } }
        if (lane < 8) *(v4u*)(A2 + (size_t)tok * KLORA + 320 + lane * 8) = (v4u){0u, 0u, 0u, 0u};
        const float pos = (float)(p < 16 ? (t >> 6) : (t & 63));
        const float rev = __builtin_amdgcn_fractf(pos * invf);
        const float sn = __builtin_amdgcn_sinf(rev), cs = __builtin_amdgcn_cosf(rev);
#pragma unroll
        for (int i = 0; i < 5; ++i) { const int hh = half + 2 * i;
            const unsigned w = qw5[i];
            const float x1 = bf_lo(w), x2 = bf_hi(w);
            float ss = x1 * x1 + x2 * x2;
            ss += __shfl_xor(ss, 1); ss += __shfl_xor(ss, 2); ss += __shfl_xor(ss, 4); ss += __shfl_xor(ss, 8); ss += __shfl_xor(ss, 16);
            const float rs = 1.0f / sqrtf(ss * (1.f / 64.f) + 1e-6f);
            const bool isq = hh < 8;
            const float y1 = x1 * rs * (isq ? gq0 : gk0), y2 = x2 * rs * (isq ? gq1 : gk1);
            float o1 = y1 * cs - y2 * sn, o2 = y1 * sn + y2 * cs;
            if (isq) { o1 *= attn_body::C2; o2 *= attn_body::C2; }
            *(unsigned*)(qrow + hh * 64 + 2 * p) = pk2(o1, o2); }
    }
}

constexpr int RW_TC = 32, RW_ARR = RW_TC * 64, RW_BUF = 6 * RW_ARR, RW_NCH = T / RW_TC;
__device__ __forceinline__ void rwkv_chain(const Args& a, LAS unsigned char* lds, int chain2, int tid, int wave, int lane) {
    const int chain = chain2 >> 1, half = chain2 & 1;
    const int b = chain >> 4, h = (chain >> 1) & 7, dir = chain & 1;
    LAS float* buf = (LAS float*)lds;
    if (wave >= 4) {
        const bf16* Rb = (const bf16*)(a.ws + WS_R); const bf16* Kb = (const bf16*)(a.ws + WS_K); const bf16* Vb = (const bf16*)(a.ws + WS_V);
        const bf16* Ab = (const bf16*)a.out + (size_t)2 * M * 512; const bf16* Db = (const bf16*)a.out + (size_t)dir * M * 512;
        const int ltid = tid - 256, ls = ltid >> 3, lc = (ltid & 7) * 8;
        const size_t gbase = (size_t)b * T * 512 + h * 64 + lc;
        float kk8[8], ka8[8];
#pragma unroll
        for (int j = 0; j < 8; ++j) { kk8[j] = a.in[15][h * 64 + lc + j]; ka8[j] = a.in[16][h * 64 + lc + j]; }
        v4u rR, rK, rV, rA, rD;
#define RW_LOAD(c) do { int t_ = (c) * RW_TC + ls; if (dir) t_ = T - 1 - t_; const size_t o_ = gbase + (size_t)t_ * 512; \
        rR = *(const v4u*)(Rb + o_); rK = *(const v4u*)(Kb + o_); rV = *(const v4u*)(Vb + o_); rA = *(const v4u*)(Ab + o_); rD = *(const v4u*)(Db + o_); } while (0)
#define RW_STAGE(c) do { LAS float* B_ = buf + ((c) & 1) * RW_BUF + ls * 64 + lc; \
        float r8[8], k8[8], v8[8], a8[8], d8[8], n8[8]; unpack8(rR, r8); unpack8(rK, k8); unpack8(rV, v8); unpack8(rA, a8); unpack8(rD, d8); \
        float ss_ = 0.f; _Pragma("unroll") for (int j = 0; j < 8; ++j) { n8[j] = k8[j] * kk8[j]; ss_ += n8[j] * n8[j]; } \
        ss_ = sum8(ss_); const float inv_ = 1.0f / fmaxf(sqrtf(ss_), 1e-12f); \
        f32x4 o0, o1; \
        _Pragma("unroll") for (int j = 0; j < 4; ++j) { o0[j] = -n8[j] * inv_; o1[j] = -n8[4 + j] * inv_; } *(LAS f32x4*)(B_ + 0 * RW_ARR) = o0; *(LAS f32x4*)(B_ + 0 * RW_ARR + 4) = o1; \
        _Pragma("unroll") for (int j = 0; j < 4; ++j) { o0[j] = n8[j] * inv_ * a8[j]; o1[j] = n8[4 + j] * inv_ * a8[4 + j]; } *(LAS f32x4*)(B_ + 1 * RW_ARR) = o0; *(LAS f32x4*)(B_ + 1 * RW_ARR + 4) = o1; \
        _Pragma("unroll") for (int j = 0; j < 4; ++j) { o0[j] = __expf(-d8[j]); o1[j] = __expf(-d8[4 + j]); } *(LAS f32x4*)(B_ + 2 * RW_ARR) = o0; *(LAS f32x4*)(B_ + 2 * RW_ARR + 4) = o1; \
        _Pragma("unroll") for (int j = 0; j < 4; ++j) { o0[j] = k8[j] * (1.0f + (a8[j] - 1.0f) * ka8[j]); o1[j] = k8[4 + j] * (1.0f + (a8[4 + j] - 1.0f) * ka8[4 + j]); } *(LAS f32x4*)(B_ + 3 * RW_ARR) = o0; *(LAS f32x4*)(B_ + 3 * RW_ARR + 4) = o1; \
        _Pragma("unroll") for (int j = 0; j < 4; ++j) { o0[j] = r8[j]; o1[j] = r8[4 + j]; } *(LAS f32x4*)(B_ + 4 * RW_ARR) = o0; *(LAS f32x4*)(B_ + 4 * RW_ARR + 4) = o1; \
        _Pragma("unroll") for (int j = 0; j < 4; ++j) { o0[j] = v8[j]; o1[j] = v8[4 + j]; } *(LAS f32x4*)(B_ + 5 * RW_ARR) = o0; *(LAS f32x4*)(B_ + 5 * RW_ARR + 4) = o1; } while (0)
        RW_LOAD(0); RW_STAGE(0); RW_LOAD(1);
        __syncthreads();
        for (int c = 0; c < RW_NCH; ++c) {
            if (c + 1 < RW_NCH) { RW_STAGE(c + 1); if (c + 2 < RW_NCH) RW_LOAD(c + 2); }
            __syncthreads();
        }
#undef RW_LOAD
#undef RW_STAGE
    } else {
        bf16* Yb = (bf16*)(a.ws + (dir ? WS_YB : WS_YF));
        LAS float* yst = (LAS float*)(lds + 2 * RW_BUF * 4) + wave * 256;
        const int r8 = lane >> 3, ks = (lane & 7) * 8;
        f32x2 S0[4];
#pragma unroll
        for (int i = 0; i < 4; ++i) S0[i] = (f32x2){0.f, 0.f};
        __syncthreads();
        for (int c = 0; c < RW_NCH; ++c) {
            const LAS float* Bk = buf + (c & 1) * RW_BUF + ks; const LAS float* Bv = buf + (c & 1) * RW_BUF + 5 * RW_ARR + half * 32 + wave * 8 + r8;
            f32x4 na0 = *(const LAS f32x4*)(Bk + 0 * RW_ARR), na1 = *(const LAS f32x4*)(Bk + 0 * RW_ARR + 4), nb0 = *(const LAS f32x4*)(Bk + 1 * RW_ARR), nb1 = *(const LAS f32x4*)(Bk + 1 * RW_ARR + 4);
            f32x4 nw0 = *(const LAS f32x4*)(Bk + 2 * RW_ARR), nw1 = *(const LAS f32x4*)(Bk + 2 * RW_ARR + 4), nk0 = *(const LAS f32x4*)(Bk + 3 * RW_ARR), nk1 = *(const LAS f32x4*)(Bk + 3 * RW_ARR + 4);
            f32x4 nr0 = *(const LAS f32x4*)(Bk + 4 * RW_ARR), nr1 = *(const LAS f32x4*)(Bk + 4 * RW_ARR + 4); float nvv = *Bv;
#pragma unroll 2
            for (int s = 0; s < RW_TC; ++s) {
                const f32x4 a0 = na0, a1 = na1, b0 = nb0, b1 = nb1, w0 = nw0, w1 = nw1, k0 = nk0, k1 = nk1, r0 = nr0, r1 = nr1; const float vv = nvv;
                { const int sn = (s + 1 < RW_TC) ? s + 1 : s; const LAS float* Bs = Bk + sn * 64;
                  na0 = *(const LAS f32x4*)(Bs + 0 * RW_ARR); na1 = *(const LAS f32x4*)(Bs + 0 * RW_ARR + 4); nb0 = *(const LAS f32x4*)(Bs + 1 * RW_ARR); nb1 = *(const LAS f32x4*)(Bs + 1 * RW_ARR + 4);
                  nw0 = *(const LAS f32x4*)(Bs + 2 * RW_ARR); nw1 = *(const LAS f32x4*)(Bs + 2 * RW_ARR + 4); nk0 = *(const LAS f32x4*)(Bs + 3 * RW_ARR); nk1 = *(const LAS f32x4*)(Bs + 3 * RW_ARR + 4);
                  nr0 = *(const LAS f32x4*)(Bs + 4 * RW_ARR); nr1 = *(const LAS f32x4*)(Bs + 4 * RW_ARR + 4); nvv = Bv[sn * 64]; }
                const f32x2 av[4] = {{a0.x, a0.y}, {a0.z, a0.w}, {a1.x, a1.y}, {a1.z, a1.w}}, bv[4] = {{b0.x, b0.y}, {b0.z, b0.w}, {b1.x, b1.y}, {b1.z, b1.w}};
                const f32x2 wv[4] = {{w0.x, w0.y}, {w0.z, w0.w}, {w1.x, w1.y}, {w1.z, w1.w}}, kv[4] = {{k0.x, k0.y}, {k0.z, k0.w}, {k1.x, k1.y}, {k1.z, k1.w}};
                const f32x2 rv[4] = {{r0.x, r0.y}, {r0.z, r0.w}, {r1.x, r1.y}, {r1.z, r1.w}};
                const f32x2 p0 = (S0[0] * av[0] + S0[1] * av[1]) + (S0[2] * av[2] + S0[3] * av[3]);
                const float sa0 = sum8(p0.x + p0.y);
                const f32x2 v0 = {vv, vv}, s0 = {sa0, sa0};
#pragma unroll
                for (int i = 0; i < 4; ++i) S0[i] = S0[i] * wv[i] + (v0 * kv[i] + s0 * bv[i]);
                const f32x2 q0 = (S0[0] * rv[0] + S0[1] * rv[1]) + (S0[2] * rv[2] + S0[3] * rv[3]);
                const float y0 = sum8(q0.x + q0.y);
                yst[s * 8 + r8] = y0;
            }
            LDS_WAIT();
            if (lane < 32) { const f32x4 y0 = *(const LAS f32x4*)(yst + lane * 8), y1 = *(const LAS f32x4*)(yst + lane * 8 + 4);
                int t_ = c * RW_TC + lane; if (dir) t_ = T - 1 - t_;
                v4u w; w.x = pk2(y0.x, y0.y); w.y = pk2(y0.z, y0.w); w.z = pk2(y1.x, y1.y); w.w = pk2(y1.z, y1.w);
                *(v4u*)(Yb + ((size_t)b * T + t_) * 512 + h * 64 + half * 32 + wave * 8) = w; }
            LDS_WAIT();
            __syncthreads();
        }
    }
    __syncthreads();
}

__device__ __forceinline__ void phase_post(const Args& a, int gw, int NGW, int lane) {
    const bf16* Rb = (const bf16*)(a.ws + WS_R); const bf16* Kb = (const bf16*)(a.ws + WS_K); const bf16* Vb = (const bf16*)(a.ws + WS_V);
    const bf16* Ab = (const bf16*)a.out + (size_t)2 * M * 512; const bf16* Gb = (const bf16*)a.out + (size_t)3 * M * 512;
    const bf16* YF = (const bf16*)(a.ws + WS_YF); const bf16* YB = (const bf16*)(a.ws + WS_YB);
    bf16* QKV = (bf16*)(a.ws + WS_QKV);
    const int ch = lane * 8;
    float ka[8], rk[8], lg[8], lb[8];
#pragma unroll
    for (int j = 0; j < 8; ++j) { ka[j] = a.in[16][ch + j]; rk[j] = a.in[17][ch + j]; lg[j] = a.in[18][ch + j]; lb[j] = a.in[19][ch + j]; }
    for (int tok0 = gw; tok0 < M; tok0 += 2 * NGW) {
        v4u lyf[2], lyb[2], lr[2], lk[2], lv[2], la[2], lgt[2];
#pragma unroll
        for (int u = 0; u < 2; ++u) { const int tok = tok0 + u * NGW; const size_t off = (size_t)(tok < M ? tok : tok0) * 512 + ch;
            lyf[u] = *(const v4u*)(YF + off); lyb[u] = *(const v4u*)(YB + off); lr[u] = *(const v4u*)(Rb + off); lk[u] = *(const v4u*)(Kb + off);
            lv[u] = *(const v4u*)(Vb + off); la[u] = *(const v4u*)(Ab + off); lgt[u] = *(const v4u*)(Gb + off); }
        asm volatile("s_waitcnt vmcnt(0)" ::: "memory");
#pragma unroll
        for (int u = 0; u < 2; ++u) { const int tok = tok0 + u * NGW;
            float yf[8], yb[8], r[8], k[8], v[8], aa[8], g[8], o[8];
            unpack8(lyf[u], yf); unpack8(lyb[u], yb); unpack8(lr[u], r); unpack8(lk[u], k); unpack8(lv[u], v); unpack8(la[u], aa); unpack8(lgt[u], g);
            float s = 0.f, bs = 0.f;
#pragma unroll
            for (int j = 0; j < 8; ++j) { yf[j] += yb[j]; s += yf[j]; const float kt = k[j] * (1.0f + (aa[j] - 1.0f) * ka[j]); bs += r[j] * kt * rk[j]; }
            s = sum8(s); bs = sum8(bs);
            const float mean = s * (1.f / 64.f); float q = 0.f;
#pragma unroll
            for (int j = 0; j < 8; ++j) { yf[j] -= mean; q += yf[j] * yf[j]; }
            q = sum8(q);
            const float rstd = 1.0f / sqrtf(q * (1.f / 64.f) + 64e-5f);
#pragma unroll
            for (int j = 0; j < 8; ++j) o[j] = (yf[j] * rstd * lg[j] + lb[j] + bs * v[j]) * g[j];
            if (tok < M) *(v4u*)(QKV + (size_t)tok * 1280 + ch) = pack8f(o); }
    }
}
constexpr int S5_LC = 64, S5_NCH = T / S5_LC, S5_SC = 16;
constexpr int S5_BU_STRIDE = 132, S5_ST_STRIDE = 136, S5_WAVE_LDS = 16 * S5_BU_STRIDE * 4 + 16 * S5_ST_STRIDE * 2;
__device__ __forceinline__ float gelu_tanh(float y) { const float u = 0.7978845608028654f * (y + 0.044715f * y * y * y); return 0.5f * y * (1.0f + ftanh(u)); }
__device__ __forceinline__ void s5_consts(const Args& a, int g, int p, int dir, float& lbr, float& lbi, float& cr, float& ci) {
    const float lr = (dir ? a.in[26] : a.in[23])[g * 64 + p], li = (dir ? a.in[27] : a.in[24])[g * 64 + p], dt = expf((dir ? a.in[28] : a.in[25])[g]);
    const float mag = expf(lr * dt); const float rev = __builtin_amdgcn_fractf(li * dt * 0.15915494309189535f); const float sn = __builtin_amdgcn_sinf(rev), cs = __builtin_amdgcn_cosf(rev);
    lbr = mag * cs; lbi = mag * sn;
    const float nr = lbr - 1.0f, ni = lbi, den = lr * lr + li * li;
    cr = (nr * lr + ni * li) / den; ci = (ni * lr - nr * li) / den;
}
struct S5Ops { bf16x8 Bop[8]; bf16x8 Cop[4]; float lbr, lbi; };
template <int PASS, int DIR>
__device__ __forceinline__ void s5_build(const Args& a, int g, int lane, S5Ops& o) {
    const int n = lane & 15, kq = lane >> 4;
    float cr, ci; s5_consts(a, g, lane, DIR, o.lbr, o.lbi, cr, ci);
#pragma unroll
    for (int q = 0; q < 4; ++q) { const int pp = q * 16 + n;
        const float c_r = __shfl(cr, pp), c_i = __shfl(ci, pp);
        float br[8], bi[8];
        if (kq < 2) { const f32x4 x0 = *(const f32x4*)(a.in[29] + (size_t)(g * 64 + pp) * 16 + kq * 8), x1 = *(const f32x4*)(a.in[29] + (size_t)(g * 64 + pp) * 16 + kq * 8 + 4);
            const f32x4 y0 = *(const f32x4*)(a.in[30] + (size_t)(g * 64 + pp) * 16 + kq * 8), y1 = *(const f32x4*)(a.in[30] + (size_t)(g * 64 + pp) * 16 + kq * 8 + 4);
#pragma unroll
            for (int j = 0; j < 4; ++j) { br[j] = x0[j]; br[4 + j] = x1[j]; bi[j] = y0[j]; bi[4 + j] = y1[j]; } }
        else {
#pragma unroll
            for (int j = 0; j < 8; ++j) { br[j] = 0.f; bi[j] = 0.f; } }
        float vr[8], vi[8];
#pragma unroll
        for (int j = 0; j < 8; ++j) { vr[j] = c_r * br[j] - c_i * bi[j]; vi[j] = c_r * bi[j] + c_i * br[j]; }
        o.Bop[2 * q] = __builtin_bit_cast(bf16x8, pack8f(vr)); o.Bop[2 * q + 1] = __builtin_bit_cast(bf16x8, pack8f(vi)); }
    if (PASS == 2) {
#pragma unroll
        for (int ks = 0; ks < 4; ++ks) { const int k0 = 32 * ks + 8 * kq; const float* src = (k0 < 64) ? ((DIR ? a.in[33] : a.in[31]) + (size_t)(g * 16 + n) * 64 + k0) : ((DIR ? a.in[34] : a.in[32]) + (size_t)(g * 16 + n) * 64 + (k0 - 64));
            const f32x4 x0 = *(const f32x4*)src, x1 = *(const f32x4*)(src + 4); const float sg = (k0 < 64) ? 1.0f : -1.0f; float v[8];
#pragma unroll
            for (int j = 0; j < 4; ++j) { v[j] = sg * x0[j]; v[4 + j] = sg * x1[j]; }
            o.Cop[ks] = __builtin_bit_cast(bf16x8, pack8f(v)); } }
}
template <int PASS, int DIR>
__device__ __forceinline__ void s5_dir(const Args& a, const S5Ops& o, LAS float* bu, LAS bf16* sst, LAS bf16* ust, int tok0, size_t eidx, int g, int lane, const v4u (&araw)[4], f32x2 cin, float dsk, f32x4 (&yf)[4]) {
    bf16* Z = (bf16*)(a.ws + WS_Z); f32x2* E = (f32x2*)(a.ws + WS_E);
    const int n = lane & 15, kq = lane >> 4;
    float sre = 0.f, sim = 0.f;
    if (PASS == 2) { sre = cin.x; sim = cin.y; }
    const int recol = (lane >> 4) * 32 + (lane & 15);
    const float lbr = o.lbr, lbi = o.lbi;
#pragma unroll
    for (int sc = 0; sc < 4; ++sc) { const int sci = DIR ? 3 - sc : sc; const int t0 = tok0 + sci * S5_SC;
        const bf16x8 Aop = __builtin_bit_cast(bf16x8, araw[sci]);
        if (PASS == 2 && DIR == 1 && kq < 2) *(LAS v4u*)(ust + n * 16 + kq * 8) = araw[sci];
        pg8::f32x4 acc[8];
#pragma unroll
        for (int nt = 0; nt < 8; ++nt) acc[nt] = __builtin_amdgcn_mfma_f32_16x16x32_bf16(Aop, o.Bop[nt], (pg8::f32x4){0.f, 0.f, 0.f, 0.f}, 0, 0, 0);
#pragma unroll
        for (int nt = 0; nt < 8; ++nt)
#pragma unroll
            for (int j = 0; j < 4; ++j) bu[(4 * kq + j) * S5_BU_STRIDE + nt * 16 + n] = acc[nt][j];
        LDS_WAIT();
        float bre[16], bim[16];
#pragma unroll
        for (int t = 0; t < 16; ++t) { bre[t] = bu[t * S5_BU_STRIDE + recol]; bim[t] = bu[t * S5_BU_STRIDE + recol + 16]; }
        LDS_WAIT();
        float sr[16], si[16];
#pragma unroll
        for (int tt = 0; tt < 16; ++tt) { const int t = DIR ? 15 - tt : tt;
            const float nre = lbr * sre + (bre[t] - lbi * sim), nim = lbr * sim + (lbi * sre + bim[t]);
            sre = nre; sim = nim; sr[t] = sre; si[t] = sim; }
        if (PASS == 2) {
#pragma unroll
            for (int t = 0; t < 16; ++t) { sst[t * S5_ST_STRIDE + lane] = (bf16)(pk2(sr[t], 0.f) & 0xffffu); sst[t * S5_ST_STRIDE + 64 + lane] = (bf16)(pk2(si[t], 0.f) & 0xffffu); } }
        if (PASS == 2) {
            LDS_WAIT();
            pg8::f32x4 y = (pg8::f32x4){0.f, 0.f, 0.f, 0.f};
#pragma unroll
            for (int ks = 0; ks < 4; ++ks) { const bf16x8 A2 = *(const LAS bf16x8*)(sst + n * S5_ST_STRIDE + ks * 32 + kq * 8); y = __builtin_amdgcn_mfma_f32_16x16x32_bf16(A2, o.Cop[ks], y, 0, 0, 0); }
            if (DIR == 0) { yf[sci] = y; }
            else {
#pragma unroll
                for (int j = 0; j < 4; ++j) { const float uv = bf1(ust[(4 * kq + j) * 16 + n]);
                    const float yy = y[j] + yf[sci][j] + uv * dsk; Z[(size_t)(t0 + 4 * kq + j) * 1024 + g * 16 + n] = (bf16)(pk2(gelu_tanh(yy), 0.f) & 0xffffu); } }
        }
        LDS_WAIT();
    }
    if (PASS == 1) E[eidx] = (f32x2){sre, sim};
}
template <int PASS>
__device__ __forceinline__ void phase_s5(const Args& a, LAS unsigned char* lds, int gw, int NGW, int wave, int lane) {
    constexpr int WL = S5_WAVE_LDS + 512;
    LAS float* bu = (LAS float*)(lds + wave * WL); LAS bf16* sst = (LAS bf16*)(lds + wave * WL + 16 * S5_BU_STRIDE * 4); LAS bf16* ust = (LAS bf16*)(lds + wave * WL + S5_WAVE_LDS);
    const bf16* XN = (const bf16*)(a.ws + WS_XN); const f32x2* CIN = (const f32x2*)(a.ws + WS_CIN);
    const int g = gw & 63, slot = gw >> 6, nslots = NGW >> 6, n = lane & 15, kq = lane >> 4;
    if (slot >= nslots) return;
    S5Ops of, ob; s5_build<PASS, 0>(a, g, lane, of); s5_build<PASS, 1>(a, g, lane, ob);
    const float dsk = (PASS == 2) ? a.in[35][g * 16 + n] : 0.f;
    constexpr int NPAIR = NB * S5_NCH;
    v4u nA[4]; f32x2 ncf = {0.f, 0.f}, ncb = {0.f, 0.f};
#define S5_PREFETCH(pi_) do { const int b_ = (pi_) >> 7, ch_ = (pi_) & (S5_NCH - 1); const size_t r0_ = (size_t)(b_ * T + ch_ * S5_LC + n) * 1024 + g * 16 + kq * 8; \
        _Pragma("unroll") for (int q_ = 0; q_ < 4; ++q_) { nA[q_] = (v4u){0u, 0u, 0u, 0u}; if (kq < 2) nA[q_] = *(const v4u*)(XN + r0_ + (size_t)q_ * S5_SC * 1024); } \
        if (PASS == 2) { const size_t e_ = ((((size_t)b_) * 64 + g) * S5_NCH + ch_) * 64 + lane; ncf = CIN[e_]; ncb = CIN[e_ + (size_t)NB * 64 * S5_NCH * 64]; } } while (0)
    if (slot < NPAIR) S5_PREFETCH(slot);
    for (int pi = slot; pi < NPAIR; pi += nslots) { const int b = pi >> 7, chunk = pi & (S5_NCH - 1);
        asm volatile("s_waitcnt vmcnt(0)" ::: "memory");
        v4u cA[4];
#pragma unroll
        for (int q = 0; q < 4; ++q) cA[q] = nA[q];
        const f32x2 ccf = ncf, ccb = ncb;
        if (pi + nslots < NPAIR) S5_PREFETCH(pi + nslots);
        f32x4 yf[4];
#pragma unroll
        for (int i = 0; i < 4; ++i) yf[i] = (f32x4){0.f, 0.f, 0.f, 0.f};
        const int tok0 = b * T + chunk * S5_LC; const size_t e0 = ((((size_t)b) * 64 + g) * S5_NCH + chunk) * 64 + lane;
        s5_dir<PASS, 0>(a, of, bu, sst, ust, tok0, e0, g, lane, cA, ccf, dsk, yf);
        s5_dir<PASS, 1>(a, ob, bu, sst, ust, tok0, e0 + (size_t)NB * 64 * S5_NCH * 64, g, lane, cA, ccb, dsk, yf);
    }
#undef S5_PREFETCH
}
__device__ __forceinline__ void phase_s5_prefix(const Args& a, int gw, int NGW, int lane) {
    const f32x2* E = (const f32x2*)(a.ws + WS_E); f32x2* CIN = (f32x2*)(a.ws + WS_CIN);
    for (int u = gw; u < 2 * NB * 64; u += NGW) { const int g = u & 63, dir = u / (NB * 64);
        float lbr, lbi, cr, ci; s5_consts(a, g, lane, dir, lbr, lbi, cr, ci);
#pragma unroll
        for (int i = 0; i < 6; ++i) { const float r2 = lbr * lbr - lbi * lbi, i2 = 2.0f * lbr * lbi; lbr = r2; lbi = i2; }
        const size_t base = (size_t)u * S5_NCH * 64 + lane;
        float cre = 0.f, cim = 0.f;
        for (int k0 = 0; k0 < S5_NCH; k0 += 16) {
            f32x2 e[16];
#pragma unroll
            for (int i = 0; i < 16; ++i) { const int c = dir ? S5_NCH - 1 - (k0 + i) : (k0 + i); e[i] = E[base + (size_t)c * 64]; }
            asm volatile("s_waitcnt vmcnt(0)" ::: "memory");
#pragma unroll
            for (int i = 0; i < 16; ++i) { const int c = dir ? S5_NCH - 1 - (k0 + i) : (k0 + i);
                CIN[base + (size_t)c * 64] = (f32x2){cre, cim};
                const float nr = lbr * cre - lbi * cim + e[i].x, ni = lbr * cim + lbi * cre + e[i].y; cre = nr; cim = ni; }
        }
    }
}
#ifndef SKIPMASK
#define SKIPMASK 0
#endif
#define ON(n) (!((SKIPMASK >> (n)) & 1))
typedef const __attribute__((address_space(4))) Args* KArgP;
#define PHASE_BEGIN() \
    KArgP ap_ = (KArgP)__builtin_amdgcn_kernarg_segment_ptr(); asm volatile("" : "+s"(ap_)); const Args a = *ap_; \
    int tid = threadIdx.x; asm volatile("" : "+v"(tid)); const int lane = tid & 63, wave = __builtin_amdgcn_readfirstlane(tid >> 6); \
    int bx = blockIdx.x; asm volatile("" : "+s"(bx)); int G = gridDim.x; asm volatile("" : "+s"(G)); \
    const int gw = bx * NWAVES + wave, NGW = G * NWAVES; unsigned char* const ws = a.ws; \
    (void)lane; (void)gw; (void)NGW; (void)ws; (void)tid

__global__ void __launch_bounds__(NTHREADS, 2) mega_fwd(Args a_unused) {
#if defined(__HIP_DEVICE_COMPILE__)
    extern __shared__ __attribute__((aligned(16))) unsigned char lds_raw[];
    cg::grid_group grid = cg::this_grid();
    LAS unsigned char* const lds = (LAS unsigned char*)lds_raw;
    if (threadIdx.x < 4) ((LAS unsigned*)(lds + LDS_BARST))[threadIdx.x] = 0u;
    __syncthreads();
    XcdBarrier xbar; xbar.bar = nullptr; xbar.x = 0; xbar.st = nullptr;

    if (ON(0)) { PHASE_BEGIN();
        bf16* WIN = (bf16*)(ws + WS_WIN); bf16* WLORA = (bf16*)(ws + WS_WLORA); bf16* XN = (bf16*)(ws + WS_XN);
        LAS float* scr = (LAS float*)(lds + wave * 16384);
        if (bx == 0) { if (tid < 64) ((unsigned*)(ws + WS_CTL))[tid] = 0u; for (int i = tid; i < XCD_BAR_WORDS; i += NTHREADS) ((unsigned*)(ws + WS_BAR))[i] = 0u; }
        {
            const int nblk = 2624 / 32, nit = 16 * nblk;
            for (int it = gw; it < nit; it += NGW) { const int kb = it / nblk, nb = it % nblk; const int drow = nb < 58 ? 768 + 32 * nb : 32 * (nb - 58);
                transpose_item(a.in[6], 2624, WIN, 1024, 64 * kb, 32 * nb, drow, scr, lane); }
        }
        for (int i = bx * NTHREADS + tid; i < (NIN - 2624) * 1024 / 8; i += G * NTHREADS) *(v4u*)(WIN + (size_t)2624 * 1024 + (size_t)i * 8) = (v4u){0u, 0u, 0u, 0u};
        for (int i = bx * NTHREADS + tid; i < NLORA * KLORA; i += G * NTHREADS) { const int n = i / KLORA, k = i % KLORA; const int which = n >> 9, nn = n & 511; float v = 0.f;
            if (which == 0) { if (k < 64) v = a.in[9][k * 512 + nn]; }
            else if (which == 1) { if (k >= 64 && k < 128) v = a.in[11][(k - 64) * 512 + nn]; }
            else if (which == 2) { if (k >= 128 && k < 192) v = a.in[13][(k - 128) * 512 + nn]; }
            else { if (k >= 192 && k < 320) v = a.in[14][(k - 192) * 512 + nn]; }
            WLORA[i] = (bf16)(pk2(v, 0.f) & 0xffffu); }
        for (int i = bx * NTHREADS + tid; i < NLORA; i += G * NTHREADS) { const int which = i >> 9, nn = i & 511; ((float*)(ws + WS_LBIAS))[i] = which == 0 ? a.in[8][nn] : (which == 1 ? a.in[10][nn] : (which == 2 ? a.in[12][nn] : 0.f)); }
        rms_all(a.in[0], a.in[1], MPROMPT, a.in[2], XN, gw, NGW, lane);
    }
    grid.sync();
    { PHASE_BEGIN(); xbar = xcd_barrier_post((unsigned*)(ws + WS_BAR), (volatile LAS unsigned*)(lds + LDS_BARST)); }
    if (ON(1)) { PHASE_BEGIN();
        pg8::Gemm g{(const bf16*)(ws + WS_XN), (const bf16*)(ws + WS_WIN), M, NIN, D, D}; pg8::StaticOrder S; S.init(M, NIN, G, bx);
        pg8::EpiInProj E{(bf16*)(ws + WS_QKV), (bf16*)a.out};
        pg8::gemm_phase<pg8::EpiInProj, pg8::StaticOrder, true, true>(lds, g, S, E);
    }
    xcd_barrier(xbar);
    if (ON(2)) { PHASE_BEGIN(); phase_shift_qk(a, gw, NGW, lane); }
    xcd_barrier(xbar);
    if (ON(3)) { PHASE_BEGIN();
        pg8::Gemm g{(const bf16*)(ws + WS_A2), (const bf16*)(ws + WS_WLORA), M, NLORA, KLORA, KLORA}; pg8::StaticOrder S; S.init(M, NLORA, G, bx);
        pg8::EpiLora E{(bf16*)a.out, (size_t)M * 512, (const float*)(ws + WS_LBIAS)};
        pg8::gemm_phase<pg8::EpiLora, pg8::StaticOrder, true, true>(lds, g, S, E);
    }
    xcd_barrier(xbar);
    if (ON(4)) { PHASE_BEGIN();
        bf16* QKV = (bf16*)(ws + WS_QKV);
        const attn_body::bf16* Qp = (const attn_body::bf16*)(QKV + 512); const attn_body::bf16* Kp = (const attn_body::bf16*)(QKV + 1024); const attn_body::bf16* Vp = (const attn_body::bf16*)(QKV + 1152);
        attn_body::bf16* Op = (attn_body::bf16*)(QKV + 512);
        unsigned* ctr = (unsigned*)(ws + WS_CTL);
        volatile LAS unsigned* qw = (volatile LAS unsigned*)(lds + LDS_QWORD);
        for (;;) {
            if (tid == 0) *qw = __hip_atomic_fetch_add(ctr, 1u, __ATOMIC_RELAXED, __HIP_MEMORY_SCOPE_AGENT);
            __syncthreads();
            const int id = (int)__builtin_amdgcn_readfirstlane(*qw);
            __syncthreads();
            if (id >= 192 + 1536 + 160) break;
            if (id >= 192 + 1536) {
                LAS float* scr = (LAS float*)(lds + wave * 16384);
#pragma unroll 1
                for (int q = 0; q < 4; ++q) { int it = (id - (192 + 1536)) * 32 + wave * 4 + q;
                    if (it < 512) { transpose_item(a.in[22], 1024, (bf16*)(ws + WS_WOUT), 1024, 64 * (it >> 5), 32 * (it & 31), 32 * (it & 31), scr, lane); continue; } it -= 512;
                    if (it < 512) { transpose_item(a.in[36], 1024, (bf16*)(ws + WS_WGLU), 1024, 64 * (it >> 5), 32 * (it & 31), 32 * (it & 31), scr, lane); continue; } it -= 512;
                    if (it < 2048) { transpose_item(a.in[4], 4096, (bf16*)(ws + WS_WUP), 1024, 64 * (it >> 7), 32 * (it & 127), 32 * (it & 127), scr, lane); continue; } it -= 2048;
                    transpose_item(a.in[5], 1024, (bf16*)(ws + WS_WDN), 4096, 64 * (it >> 5), 32 * (it & 31), 32 * (it & 31), scr, lane); }
                continue; }
            if (id < 192) rwkv_chain(a, lds, id, tid, wave, lane);
            else { const int u = id - 192; const int bk = u >> 7, rem = u & 127; const int b = bk >> 1, h = (bk & 1) * 4 + (rem >> 5), qb = rem & 31;
                attn_body::attn_unit<8>(b, h, qb, Qp, Kp, Vp, Op, (char*)lds_raw); }
        }
    }
    xcd_barrier(xbar);
    if (ON(6)) { PHASE_BEGIN(); phase_post(a, gw, NGW, lane); }
    xcd_barrier(xbar);
    if (ON(7)) { PHASE_BEGIN();
        pg8::Gemm g{(const bf16*)(ws + WS_QKV), (const bf16*)(ws + WS_WOUT), M, D, D, 1280}; pg8::StaticOrder S; S.init(M, D, G, bx);
        pg8::EpiRes<0> E{a.in[0], a.in[1], a.out, nullptr, nullptr};
        pg8::gemm_phase<pg8::EpiRes<0>, pg8::StaticOrder, true, true>(lds, g, S, E);
    }
    xcd_barrier(xbar);
#pragma unroll
    for (int layer = 0; layer < 2; ++layer) {
        if (ON(8) && layer == 1) {
            { PHASE_BEGIN(); bf16* XN = (bf16*)(ws + WS_XN); LAS float* scr = (LAS float*)(lds + wave * 16384);
              rms_all(a.out, a.out, M, a.in[2] + D, XN, gw, NGW, lane);
              transpose_matrix(a.in[4] + (size_t)D * FF, 1024, 4096, (bf16*)(ws + WS_WUP), scr, gw, NGW, lane);
              transpose_matrix(a.in[5] + (size_t)D * FF, 4096, 1024, (bf16*)(ws + WS_WDN), scr, gw, NGW, lane); }
            xcd_barrier(xbar);
            if (ON(9)) { PHASE_BEGIN(); phase_s5<1>(a, lds, gw, NGW, wave, lane); }
            xcd_barrier(xbar);
            if (ON(10)) { PHASE_BEGIN(); phase_s5_prefix(a, gw, NGW, lane); }
            xcd_barrier(xbar);
            if (ON(11)) { PHASE_BEGIN(); phase_s5<2>(a, lds, gw, NGW, wave, lane); }
            xcd_barrier(xbar);
            if (ON(12)) { PHASE_BEGIN();
                pg8::Gemm g{(const bf16*)(ws + WS_Z), (const bf16*)(ws + WS_WGLU), M, D, D, D}; pg8::StaticOrder S; S.init(M, D, G, bx);
                pg8::EpiRes<2> E{nullptr, nullptr, a.out, (const bf16*)(ws + WS_Z), a.in[37]};
                pg8::gemm_phase<pg8::EpiRes<2>, pg8::StaticOrder, true, true>(lds, g, S, E);
            }
            xcd_barrier(xbar);
        }
        { PHASE_BEGIN(); bf16* XN = (bf16*)(ws + WS_XN); rms_all(a.out, a.out, M, a.in[3] + layer * D, XN, gw, NGW, lane); }
        xcd_barrier(xbar);
        if (ON(13)) { PHASE_BEGIN();
            pg8::Gemm g{(const bf16*)(ws + WS_XN), (const bf16*)(ws + WS_WUP), M, FF, D, D}; pg8::StaticOrder S; S.init(M, FF, G, bx);
            pg8::EpiUp E{(bf16*)(ws + WS_HID)};
            pg8::gemm_phase<pg8::EpiUp, pg8::StaticOrder, true, true>(lds, g, S, E);
        }
        xcd_barrier(xbar);
        if (ON(14)) { PHASE_BEGIN();
            pg8::Gemm g{(const bf16*)(ws + WS_HID), (const bf16*)(ws + WS_WDN), M, D, FF, FF}; pg8::StaticOrder S; S.init(M, D, G, bx);
            pg8::EpiRes<1> E{nullptr, nullptr, a.out, nullptr, nullptr};
            pg8::gemm_phase<pg8::EpiRes<1>, pg8::StaticOrder, true, true>(lds, g, S, E);
        }
        if (layer == 0) xcd_barrier(xbar);
    }
#endif
}

extern "C" void kernel_launch(void* const* d_in, const int* in_sizes, int n_in, void* d_out, int out_size, void* d_ws, size_t ws_size, hipStream_t stream) {
    static int grid = 0;
    if (grid == 0) {
        if (n_in != 38 || out_size != M * D || ws_size < WS_END) { fprintf(stderr, "kernel_launch: unexpected shapes: n_in %d out %d ws %zu\n", n_in, out_size, ws_size); grid = -1; return; }
        int dev = 0, cus = 0, per_cu = 0;
        if (hipGetDevice(&dev) != hipSuccess || hipDeviceGetAttribute(&cus, hipDeviceAttributeMultiprocessorCount, dev) != hipSuccess) { fprintf(stderr, "kernel_launch: device query failed\n"); grid = -1; return; }
        if (hipFuncSetAttribute((const void*)mega_fwd, hipFuncAttributeMaxDynamicSharedMemorySize, LDS_BYTES) != hipSuccess) { fprintf(stderr, "kernel_launch: hipFuncSetAttribute failed\n"); grid = -1; return; }
        if (hipOccupancyMaxActiveBlocksPerMultiprocessor(&per_cu, (const void*)mega_fwd, NTHREADS, LDS_BYTES) != hipSuccess || per_cu < 1) { fprintf(stderr, "kernel_launch: occupancy query says %d\n", per_cu); per_cu = 1; }
        (void)hipGetLastError();
        grid = cus * per_cu;
    }
    if (grid < 0) return;
    Args a{};
    for (int i = 0; i < 38; ++i) a.in[i] = (const float*)d_in[i];
    a.out = (float*)d_out; a.ws = (unsigned char*)d_ws;
    void* args[] = {&a};
    hipError_t e = hipLaunchCooperativeKernel((const void*)mega_fwd, dim3(grid), dim3(NTHREADS), args, LDS_BYTES, stream);
    if (e != hipSuccess) fprintf(stderr, "cooperative launch failed: %s (grid %d)\n", hipGetErrorString(e), grid);
}
```

```cpp
#include <hip/hip_runtime.h>
#include <hip/hip_cooperative_groups.h>
#include <cstdio>
#include <cstdint>
namespace cg = cooperative_groups;
namespace pg8 {
#define PG8_LAS __attribute__((address_space(3)))
typedef unsigned short bf16_t;
typedef short bf16x8 __attribute__((ext_vector_type(8)));
typedef float f32x4 __attribute__((ext_vector_type(4)));
typedef unsigned u32x4 __attribute__((ext_vector_type(4)));
constexpr int BM = 256, BK = 64, HALF = 128, HTB = HALF * BK * 2  , STAGE_BYTES = 8 * HTB, NXCD = 8, WGM = 8;

__host__ __device__ __forceinline__ int lds_byte(int r, int c) { const int st = (r >> 4) * 2 + (c >> 5), rr = r & 15, cc = c & 31, ob = rr * 64 + cc * 2; return st * 1024 + (ob ^ (((ob >> 9) & 1) << 5)); }
__host__ __device__ __forceinline__ void stage_rc(int b, int& R, int& C) { const int st = b / 1024, sb = b % 1024, swz = sb ^ (((sb >> 9) & 1) << 5); R = (st >> 1) * 16 + swz / 64; C = (st & 1) * 32 + (swz % 64) / 2; }
__host__ __device__ __forceinline__ int perm32(int rho) { const int n = rho >> 4, i = rho & 15; return 8 * (i >> 2) + 4 * n + (i & 3); }

struct Unit { int pm, pn; };
struct Gemm { const bf16_t* A; const bf16_t* Bt; int M, N, K, lda, kt, kmode; };

struct StaticOrder {
    int nM, nN, nwg, G, c;
    __host__ __device__ void init(int M, int N, int G_, int c_) { nM = M / BM; nN = N / BM; nwg = nM * nN; G = G_; c = c_; }
    __host__ __device__ bool next(int i, Unit& u) const {
        const long L = (long)i * G + c; if (L >= nwg) return false;
        int wgid = (int)L; { const int q = nwg / NXCD, r = nwg % NXCD, xcd = wgid % NXCD, off = wgid / NXCD; wgid = (xcd < r ? xcd * (q + 1) : r * (q + 1) + (xcd - r) * q) + off; }
        const int nig = WGM * nN, gid = wgid / nig, fm = gid * WGM, gsz = (nM - fm) < WGM ? (nM - fm) : WGM;
        u.pm = fm + ((wgid % nig) % gsz); u.pn = (wgid % nig) / gsz; return true;
    }
    __device__ __forceinline__ void a_ready(const Unit&) const {}
    __device__ __forceinline__ void done(const Unit&) const {}
};


__device__ __forceinline__ unsigned cvt_pk_bf16(float lo, float hi) { unsigned r; asm volatile("v_cvt_pk_bf16_f32 %0, %1, %2" : "=v"(r) : "v"(lo), "v"(hi)); return r; }
typedef float cvt_f32x2_t __attribute__((ext_vector_type(2))); typedef __bf16 cvt_bf16x2_t __attribute__((ext_vector_type(2)));
__device__ __forceinline__ unsigned cvt_pk_bf16_m(float lo, float hi) { cvt_f32x2_t v = {lo, hi}; cvt_bf16x2_t b = __builtin_convertvector(v, cvt_bf16x2_t); return __builtin_bit_cast(unsigned, b); }
__device__ __forceinline__ float fsigmoid(float x) { return __builtin_amdgcn_rcpf(1.0f + __expf(-x)); }
__device__ __forceinline__ u32x4 pack8(const f32x4 v0, const f32x4 v1) { u32x4 w; w.x = cvt_pk_bf16(v0[0], v0[1]); w.y = cvt_pk_bf16(v0[2], v0[3]); w.z = cvt_pk_bf16(v1[0], v1[1]); w.w = cvt_pk_bf16(v1[2], v1[3]); return w; }

struct EpiInProj {
    static constexpr bool PERM = true, AFTER_DRAIN = false;
    bf16_t* qkv; bf16_t* hr;
    __device__ __forceinline__ void operator()(const f32x4 (&acc)[2][2][4][2], const Unit& u, int wr, int wc, int fr, int fq) const {
        bf16_t* base; int ldc;
        if (u.pn < 3) { base = qkv + 512 + u.pn * 256; ldc = 1280; } else { base = hr + (u.pn - 3) * 256; ldc = 2048; }
        const int row0 = u.pm * BM + wr * 64 + fr, col0 = wc * 32 + 8 * fq;
#pragma unroll
        for (int ai = 0; ai < 2; ++ai)
#pragma unroll
            for (int m = 0; m < 4; ++m) { bf16_t* rowp = base + (size_t)(row0 + ai * HALF + m * 16) * ldc + col0;
#pragma unroll
                for (int bj = 0; bj < 2; ++bj) { const f32x4 v0 = acc[ai][bj][m][0], v1 = acc[ai][bj][m][1]; u32x4 w; w.x = cvt_pk_bf16_m(v0[0], v0[1]); w.y = cvt_pk_bf16_m(v0[2], v0[3]); w.z = cvt_pk_bf16_m(v1[0], v1[1]); w.w = cvt_pk_bf16_m(v1[2], v1[3]); *(u32x4*)(rowp + bj * HALF) = w; } }
    }
};
struct EpiUp {
    static constexpr bool PERM = true, AFTER_DRAIN = false;
    bf16_t* O;
    __device__ __forceinline__ void operator()(const f32x4 (&acc)[2][2][4][2], const Unit& u, int wr, int wc, int fr, int fq) const {
        const int row0 = u.pm * BM + wr * 64 + fr, col0 = u.pn * BM + wc * 32 + 8 * fq;
#pragma unroll
        for (int ai = 0; ai < 2; ++ai)
#pragma unroll
            for (int m = 0; m < 4; ++m) { bf16_t* rowp = O + (size_t)(row0 + ai * HALF + m * 16) * 4096 + col0;
#pragma unroll
                for (int bj = 0; bj < 2; ++bj) { f32x4 v0 = acc[ai][bj][m][0], v1 = acc[ai][bj][m][1];
#pragma unroll
                    for (int i = 0; i < 4; ++i) { const float a = fmaxf(v0[i], 0.f), b = fmaxf(v1[i], 0.f); v0[i] = a * a; v1[i] = b * b; }
                    *(u32x4*)(rowp + bj * HALF) = pack8(v0, v1); } }
    }
};
struct EpiLora {
    static constexpr bool PERM = true, AFTER_DRAIN = false;
    bf16_t* O; size_t stride; const float* bias;
    __device__ __forceinline__ void operator()(const f32x4 (&acc)[2][2][4][2], const Unit& u, int wr, int wc, int fr, int fq) const {
        const int which = u.pn >> 1;
        const int row0 = u.pm * BM + wr * 64 + fr, col0 = (u.pn & 1) * 256 + wc * 32 + 8 * fq;
        bf16_t* base = O + (size_t)which * stride + (size_t)row0 * 512 + col0;
        const float* bp = bias + which * 512 + col0;
        const float sc = (which < 2) ? 0.60653065971f : 1.0f;
#pragma unroll
        for (int bj = 0; bj < 2; ++bj) {
            const f32x4 b0 = *(const f32x4*)(bp + bj * HALF), b1 = *(const f32x4*)(bp + bj * HALF + 4);
#pragma unroll
            for (int ai = 0; ai < 2; ++ai)
#pragma unroll
                for (int m = 0; m < 4; ++m) { f32x4 v0 = acc[ai][bj][m][0] + b0, v1 = acc[ai][bj][m][1] + b1;
                    if (which < 3) {
#pragma unroll
                        for (int i = 0; i < 4; ++i) { v0[i] = sc * fsigmoid(v0[i]); v1[i] = sc * fsigmoid(v1[i]); } }
                    *(u32x4*)(base + (size_t)(ai * HALF + m * 16) * 512 + bj * HALF) = pack8(v0, v1);
                    asm volatile("" ::: "memory"); }
        }
    }
};
template <int MODE> struct EpiRes {
    static constexpr bool PERM = false, AFTER_DRAIN = false;
    const float* xp; const float* xs; float* out; const bf16_t* z; const float* bias;
    __device__ __forceinline__ void operator()(const f32x4 (&acc)[2][2][4][2], const Unit& u, int wr, int wc, int fr, int fq) const {
        const int col0 = u.pn * BM + wc * 32 + 4 * fq;
#pragma unroll
        for (int ai = 0; ai < 2; ++ai)
#pragma unroll
            for (int m = 0; m < 4; ++m) { const int r = u.pm * BM + ai * HALF + wr * 64 + m * 16 + fr; const size_t off = (size_t)r * 1024 + col0;
#pragma unroll
                for (int bj = 0; bj < 2; ++bj)
#pragma unroll
                    for (int n = 0; n < 2; ++n) { const size_t co = off + bj * HALF + n * 16; f32x4 o;
                        if (MODE == 0) { const float* src = (r < 16384) ? (xp + co) : (xs + (co - (size_t)16384 * 1024)); o = *(const f32x4*)src + acc[ai][bj][m][n]; }
                        else if (MODE == 1) { o = *(const f32x4*)(out + co) + acc[ai][bj][m][n]; }
                        else { const unsigned long long zz = *(const unsigned long long*)(z + co); const f32x4 bv = *(const f32x4*)(bias + col0 + bj * HALF + n * 16);
                            f32x4 zf; zf[0] = __uint_as_float((unsigned)(zz << 16) & 0xffff0000u); zf[1] = __uint_as_float((unsigned)zz & 0xffff0000u);
                            zf[2] = __uint_as_float((unsigned)(zz >> 16) & 0xffff0000u); zf[3] = __uint_as_float((unsigned)(zz >> 32) & 0xffff0000u);
                            const f32x4 a = acc[ai][bj][m][n] + bv; f32x4 sg;
#pragma unroll
                            for (int i = 0; i < 4; ++i) sg[i] = fsigmoid(a[i]);
                            o = *(const f32x4*)(out + co) + zf * sg; }
                        *(f32x4*)(out + co) = o; }
                asm volatile("" ::: "memory"); }
    }
};
__device__ __forceinline__ size_t gemm_koff(int kmode, int pn) { if (!kmode) return 0; const int which = pn >> 1; const int ks = which < 2 ? 0 : (which == 2 ? 2 : 3); return (size_t)ks * (BK * 2); }
template <class Epi, class Sched, bool ALIGN_EPI = false, bool SP2 = false>
__device__ __forceinline__ void gemm_phase(PG8_LAS unsigned char* lds, const Gemm g, const Sched& S, const Epi& E) {
    int tid_ = threadIdx.x; asm volatile("" : "+v"(tid_));
    const int tid = tid_, wid = __builtin_amdgcn_readfirstlane(tid >> 6), lane = tid & 63, wr = wid >> 2, wc = wid & 3, fr = lane & 15, fq = lane >> 4;
    const int K = g.K; int nt_ = K / BK; if (g.kt) { nt_ = g.kt; asm volatile("" : "+s"(nt_)); }
    const int nt = nt_;
    unsigned voffA[2], voffB[2];
#pragma unroll
    for (int i = 0; i < 2; ++i) { int R, C; stage_rc(tid * 16 + i * 8192, R, C); const int Rb = Epi::PERM ? ((R & ~31) + perm32(R & 31)) : R;
        voffA[i] = (unsigned)(R * g.lda + C) * 2u; voffB[i] = (unsigned)(Rb * K + C) * 2u; }
    const size_t kstep = (size_t)(BK * 2);
    const size_t hstepA = (size_t)HALF * g.lda * 2, hstepB = (size_t)HALF * K * 2;
    const size_t tstepA = 2 * hstepA, tstepB = 2 * hstepB;
    const unsigned ldsw = (unsigned)wid * 1024u;
    const int aoff = lds_byte(wr * 64 + fr, fq * 8), boff = lds_byte(wc * 32 + fr, fq * 8);
#define PG8_SA(b, h) (((b) * 2 + (h)) * HTB)
#define PG8_SB(b, h) ((4 + (b) * 2 + (h)) * HTB)
#define PG8_STAGE(bufoff, gbase, voff) do { _Pragma("unroll") for (int _i = 0; _i < 2; ++_i) \
        __builtin_amdgcn_global_load_lds((const unsigned*)((const char*)(gbase) + (voff)[_i]), (PG8_LAS unsigned*)(lds + (bufoff) + ldsw + _i * 8192), 16, 0, 0); } while (0)
#define PG8_LDA(dst, b, h) do { _Pragma("unroll") for (int m = 0; m < 4; ++m) _Pragma("unroll") for (int k = 0; k < 2; ++k) dst[m][k] = *(const PG8_LAS bf16x8*)(lds + PG8_SA(b, h) + aoff + m * 2048 + k * 1024); } while (0)
#define PG8_LDB(dst, b, h) do { _Pragma("unroll") for (int n = 0; n < 2; ++n) _Pragma("unroll") for (int k = 0; k < 2; ++k) dst[n][k] = *(const PG8_LAS bf16x8*)(lds + PG8_SB(b, h) + boff + n * 2048 + k * 1024); } while (0)
#define PG8_MMA(ai, bj, At, Bt) do { __builtin_amdgcn_s_setprio(1); _Pragma("unroll") for (int m = 0; m < 4; ++m) _Pragma("unroll") for (int n = 0; n < 2; ++n) _Pragma("unroll") for (int k = 0; k < 2; ++k) \
        acc[ai][bj][m][n] = __builtin_amdgcn_mfma_f32_16x16x32_bf16(Bt[n][k], At[m][k], acc[ai][bj][m][n], 0, 0, 0); __builtin_amdgcn_s_setprio(0); } while (0)
#define PG8_WAIT_V(n) asm volatile("s_waitcnt vmcnt(" #n ")" ::: "memory")
#define PG8_WAIT_L(n) asm volatile("s_waitcnt lgkmcnt(" #n ")" ::: "memory")
#define PG8_BAR __builtin_amdgcn_s_barrier()
#define PG8_SCHED __builtin_amdgcn_sched_barrier(0)
    Unit cur, nxt; int ui = 0;
    if (!S.next(0, cur)) return;
    f32x4 acc[2][2][4][2];
#pragma unroll
    for (int a = 0; a < 2; ++a)
#pragma unroll
        for (int b = 0; b < 2; ++b)
#pragma unroll
            for (int m = 0; m < 4; ++m)
#pragma unroll
                for (int n = 0; n < 2; ++n) acc[a][b][m][n] = (f32x4){0.f, 0.f, 0.f, 0.f};
    bf16x8 At[4][2], B0[2][2], B1[2][2];
    const char* cA = (const char*)g.A + (size_t)cur.pm * tstepA + gemm_koff(g.kmode, cur.pn); const char* cB = (const char*)g.Bt + (size_t)cur.pn * tstepB + gemm_koff(g.kmode, cur.pn);
    S.a_ready(cur);
    if constexpr (SP2) {
        PG8_STAGE(PG8_SB(0, 0), cB, voffB); PG8_STAGE(PG8_SB(0, 1), cB + hstepB, voffB); PG8_STAGE(PG8_SA(0, 0), cA, voffA); PG8_STAGE(PG8_SA(0, 1), cA + hstepA, voffA);
        if (wr == 1) PG8_BAR;
        PG8_WAIT_V(2); PG8_BAR;
        PG8_STAGE(PG8_SB(1, 0), cB + kstep, voffB); PG8_STAGE(PG8_SA(1, 0), cA + kstep, voffA); PG8_STAGE(PG8_SB(1, 1), cB + hstepB + kstep, voffB);
        PG8_WAIT_V(6); PG8_BAR;
    } else {
        PG8_STAGE(PG8_SB(0, 0), cB, voffB); PG8_STAGE(PG8_SA(0, 0), cA, voffA); PG8_STAGE(PG8_SB(0, 1), cB + hstepB, voffB); PG8_STAGE(PG8_SA(0, 1), cA + hstepA, voffA);
        if (wr == 1) PG8_BAR;
        PG8_WAIT_V(4); PG8_BAR;
        PG8_STAGE(PG8_SB(1, 0), cB + kstep, voffB); PG8_STAGE(PG8_SA(1, 0), cA + kstep, voffA); PG8_STAGE(PG8_SB(1, 1), cB + hstepB + kstep, voffB);
        PG8_WAIT_V(6); PG8_BAR;
    }
    for (;;) {
        const bool has_next = S.next(ui + 1, nxt);
        const char* nA = has_next ? (const char*)g.A + (size_t)nxt.pm * tstepA + gemm_koff(g.kmode, nxt.pn) : cA; const char* nB = has_next ? (const char*)g.Bt + (size_t)nxt.pn * tstepB + gemm_koff(g.kmode, nxt.pn) : cB;
#pragma unroll 1
        for (int t = 0; t < nt; t += 2) {
            const bool last = (t == nt - 2);
            const char* a1 = cA + (size_t)(t + 1) * kstep;
            const char* a2 = last ? nA : cA + (size_t)(t + 2) * kstep; const char* b2 = last ? nB : cB + (size_t)(t + 2) * kstep;
            const char* a3 = a2 + kstep; const char* b3 = b2 + kstep;
            if (last && has_next) S.a_ready(nxt);
            if constexpr (SP2) {
            PG8_LDB(B0, 0, 0); PG8_LDB(B1, 0, 1); PG8_SCHED; PG8_LDA(At, 0, 0); PG8_STAGE(PG8_SA(1, 1), a1 + hstepA, voffA);
            PG8_WAIT_V(8); PG8_WAIT_L(0); PG8_BAR; PG8_MMA(0, 0, At, B0); PG8_MMA(0, 1, At, B1); PG8_BAR; PG8_SCHED;
            PG8_LDA(At, 0, 1); PG8_STAGE(PG8_SB(0, 0), b2, voffB); PG8_STAGE(PG8_SB(0, 1), b2 + hstepB, voffB); PG8_STAGE(PG8_SA(0, 0), a2, voffA);
            PG8_WAIT_V(8); PG8_WAIT_L(0); PG8_BAR; PG8_MMA(1, 0, At, B0); PG8_MMA(1, 1, At, B1); PG8_BAR; PG8_SCHED;
            PG8_LDB(B0, 1, 0); PG8_LDB(B1, 1, 1); PG8_SCHED; PG8_LDA(At, 1, 0); PG8_STAGE(PG8_SA(0, 1), a2 + hstepA, voffA);
            PG8_WAIT_V(8); PG8_WAIT_L(0); PG8_BAR; PG8_MMA(0, 0, At, B0); PG8_MMA(0, 1, At, B1); PG8_BAR; PG8_SCHED;
            PG8_LDA(At, 1, 1); PG8_STAGE(PG8_SB(1, 0), b3, voffB); PG8_STAGE(PG8_SB(1, 1), b3 + hstepB, voffB); PG8_STAGE(PG8_SA(1, 0), a3, voffA);
            PG8_WAIT_V(8); PG8_WAIT_L(0); PG8_BAR; PG8_MMA(1, 0, At, B0); PG8_MMA(1, 1, At, B1); PG8_BAR; PG8_SCHED;
            } else {
            PG8_LDB(B0, 0, 0); PG8_SCHED; PG8_LDA(At, 0, 0); PG8_STAGE(PG8_SA(1, 1), a1 + hstepA, voffA);
            PG8_WAIT_L(8); PG8_BAR; PG8_WAIT_L(0); PG8_MMA(0, 0, At, B0); PG8_BAR; PG8_SCHED;
            PG8_LDB(B1, 0, 1); PG8_STAGE(PG8_SB(0, 0), b2, voffB);
            PG8_BAR; PG8_WAIT_L(0); PG8_MMA(0, 1, At, B1); PG8_BAR;
            PG8_LDA(At, 0, 1); PG8_STAGE(PG8_SA(0, 0), a2, voffA);
            PG8_BAR; PG8_WAIT_L(0); PG8_MMA(1, 0, At, B0); PG8_BAR; PG8_SCHED;
            PG8_STAGE(PG8_SB(0, 1), b2 + hstepB, voffB);
            PG8_WAIT_V(6); PG8_BAR; PG8_MMA(1, 1, At, B1); PG8_BAR;
            PG8_LDB(B0, 1, 0); PG8_SCHED; PG8_LDA(At, 1, 0); PG8_STAGE(PG8_SA(0, 1), a2 + hstepA, voffA);
            PG8_WAIT_L(8); PG8_BAR; PG8_WAIT_L(0); PG8_MMA(0, 0, At, B0); PG8_BAR; PG8_SCHED;
            PG8_LDB(B1, 1, 1); PG8_STAGE(PG8_SB(1, 0), b3, voffB);
            PG8_BAR; PG8_WAIT_L(0); PG8_MMA(0, 1, At, B1); PG8_BAR;
            PG8_LDA(At, 1, 1); PG8_STAGE(PG8_SA(1, 0), a3, voffA);
            PG8_BAR; PG8_WAIT_L(0); PG8_MMA(1, 0, At, B0); PG8_BAR; PG8_SCHED;
            PG8_STAGE(PG8_SB(1, 1), b3 + hstepB, voffB);
            PG8_WAIT_V(6); PG8_BAR; PG8_MMA(1, 1, At, B1); PG8_BAR;
            }
        }
        if constexpr (ALIGN_EPI) { if (wr == 0) PG8_BAR; }
        if constexpr (!Epi::AFTER_DRAIN) { E(acc, cur, wr, wc, fr, fq); S.done(cur); }
        if (!has_next) break;
#pragma unroll
        for (int a = 0; a < 2; ++a)
#pragma unroll
            for (int b = 0; b < 2; ++b)
#pragma unroll
                for (int m = 0; m < 4; ++m)
#pragma unroll
                    for (int n = 0; n < 2; ++n) acc[a][b][m][n] = (f32x4){0.f, 0.f, 0.f, 0.f};
        cur = nxt; cA = nA; cB = nB; ++ui;
        if constexpr (ALIGN_EPI) { if (wr == 1) PG8_BAR; }
    }
    PG8_WAIT_V(0);
    if constexpr (!ALIGN_EPI) { if (wr == 0) PG8_BAR; }
    PG8_BAR;
    if constexpr (Epi::AFTER_DRAIN) { E.fused(acc, cur, wr, wc, fr, fq, lds, wid, lane); S.done(cur); }
#undef PG8_SA
#undef PG8_SB
#undef PG8_STAGE
#undef PG8_LDA
#undef PG8_LDB
#undef PG8_MMA
#undef PG8_WAIT_V
#undef PG8_WAIT_L
#undef PG8_BAR
#undef PG8_SCHED
}
}
#include <hip/hip_bf16.h>
#include <cmath>
namespace attn_body {
using bf16=__hip_bfloat16;
using bf16x8=__attribute__((ext_vector_type(8)))short;
using s16x4=__attribute__((ext_vector_type(4)))short;
using f32x16=__attribute__((ext_vector_type(16)))float;
using u32x4=__attribute__((ext_vector_type(4)))unsigned;
constexpr int BATCH=6,NHEAD=8,SEQ=8192,D=64,DM=1280;
constexpr int NW=8,QBLK=32,QB=QBLK*NW,KVBLK=64,NQB=SEQ/QB;
constexpr int ATTN_PITCH=DM, ATTN_UNIT_ROWS=QB;
__device__ __forceinline__ int crow(int r,int hi){return (r&3)+8*(r>>2)+4*hi;}
#define SBAR() __builtin_amdgcn_sched_barrier(0)
constexpr int NSLOT=3, SLOTB=8192;
constexpr int LDS_K=0, LDS_V=NSLOT*SLOTB, LDS_WS=2*NSLOT*SLOTB, LDS_OST=LDS_WS+NW*64*4, LDS_BYTES=LDS_OST+NW*4096;
constexpr float C2=0.125f*1.4426950408889634f;
__device__ __forceinline__ void glds16(const void*gsrc,unsigned lds_dst){unsigned keep;
  asm volatile("s_mov_b32 %0, m0\n\ts_mov_b32 m0, %2\n\ts_nop 0\n\tglobal_load_lds_dwordx4 %1, off\n\ts_mov_b32 m0, %0":"=&s"(keep):"v"(gsrc),"s"(lds_dst):"memory");}
__device__ __forceinline__ float max3f(float a,float b,float c){float r;asm("v_max3_f32 %0, %1, %2, %3":"=v"(r):"v"(a),"v"(b),"v"(c));return r;}
__device__ __forceinline__ float max2f(float a,float b){float r;asm("v_max_f32_e32 %0, %1, %2":"=v"(r):"v"(a),"v"(b));return r;}
__device__ __forceinline__ float fadd_s(float a,float b){float r;asm("v_add_f32_e32 %0, %1, %2":"=v"(r):"v"(a),"v"(b));return r;}
__device__ __forceinline__ float fsub_s(float a,float b){float r;asm("v_sub_f32_e32 %0, %1, %2":"=v"(r):"v"(a),"v"(b));return r;}
typedef float f32x2_t __attribute__((ext_vector_type(2))); typedef __bf16 bf16x2_t __attribute__((ext_vector_type(2)));
__device__ __forceinline__ unsigned cvtpk_s(float lo,float hi){f32x2_t v={lo,hi};bf16x2_t b=__builtin_convertvector(v,bf16x2_t);return __builtin_bit_cast(unsigned,b);}
#define WAIT_BAR(N) asm volatile("s_waitcnt vmcnt(" #N ") lgkmcnt(0)\n\ts_barrier":::"memory")

__device__ __forceinline__ void qkt(f32x16&p0,f32x16&p1,const char*Kslot,const bf16x8*qr,const f32x16&negm,int r32,int hi){
  const char*kb=Kslot+hi*1024+r32*16;
  #pragma unroll
  for(int d0=0;d0<4;++d0){
    const bf16x8 b0=*reinterpret_cast<const bf16x8*>(kb+d0*2048);
    const bf16x8 b1=*reinterpret_cast<const bf16x8*>(kb+d0*2048+512);
    if(d0==0){p0=__builtin_amdgcn_mfma_f32_32x32x16_bf16(b0,qr[0],negm,0,0,0);p1=__builtin_amdgcn_mfma_f32_32x32x16_bf16(b1,qr[0],negm,0,0,0);}
    else{p0=__builtin_amdgcn_mfma_f32_32x32x16_bf16(b0,qr[d0],p0,0,0,0);p1=__builtin_amdgcn_mfma_f32_32x32x16_bf16(b1,qr[d0],p1,0,0,0);}}
}
typedef __attribute__((address_space(3))) const char* lds_cptr;
typedef short v4i16_t __attribute__((ext_vector_type(4)));
__device__ __forceinline__ void kload8(bf16x8*kf,lds_cptr kp){
  kf[0]=*(const __attribute__((address_space(3))) bf16x8*)(kp);      kf[1]=*(const __attribute__((address_space(3))) bf16x8*)(kp+512);
  kf[2]=*(const __attribute__((address_space(3))) bf16x8*)(kp+2048); kf[3]=*(const __attribute__((address_space(3))) bf16x8*)(kp+2560);
  kf[4]=*(const __attribute__((address_space(3))) bf16x8*)(kp+4096); kf[5]=*(const __attribute__((address_space(3))) bf16x8*)(kp+4608);
  kf[6]=*(const __attribute__((address_space(3))) bf16x8*)(kp+6144); kf[7]=*(const __attribute__((address_space(3))) bf16x8*)(kp+6656);
}
__device__ __forceinline__ void kload2(bf16x8*kf,lds_cptr kp,int j){ kf[2*j]=*(const __attribute__((address_space(3))) bf16x8*)(kp+j*2048); kf[2*j+1]=*(const __attribute__((address_space(3))) bf16x8*)(kp+j*2048+512); }
__device__ __forceinline__ s16x4 vtr(lds_cptr p){ return __builtin_bit_cast(s16x4,__builtin_amdgcn_ds_read_tr16_b64_v4i16((__attribute__((address_space(3))) v4i16_t*)p)); }
__device__ __forceinline__ float rowmax(const f32x16&p0,const f32x16&p1){
  float a=max3f(p0[0],p0[1],p1[0]),b=max3f(p0[2],p0[3],p1[1]);a=max3f(a,p1[2],p1[3]);
  #pragma unroll
  for(int r=4;r<16;r+=4){a=max3f(a,p0[r],p0[r+1]);b=max3f(b,p0[r+2],p0[r+3]);a=max3f(a,p1[r],p1[r+1]);b=max3f(b,p1[r+2],p1[r+3]);}
  const float m=max2f(a,b);
  auto rr=__builtin_amdgcn_permlane32_swap(__float_as_uint(m),__float_as_uint(m),false,false);
  return max2f(__uint_as_float(rr[0]),__uint_as_float(rr[1]));
}
__device__ __forceinline__ void pv(f32x16*o,int vb,bf16x8 pa0,bf16x8 pa1,bf16x8 pa2,bf16x8 pa3){
  #pragma unroll
  for(int d0=0;d0<2;++d0){s16x4 lo[4],hi[4];
    #pragma unroll
    for(int ks=0;ks<4;++ks){
      asm volatile("ds_read_b64_tr_b16 %0,%1 offset:%c2":"=&v"(lo[ks]):"v"(vb),"i"(d0*4096+ks*1024):"memory");
      asm volatile("ds_read_b64_tr_b16 %0,%1 offset:%c2":"=&v"(hi[ks]):"v"(vb),"i"(d0*4096+ks*1024+512):"memory");}
    asm volatile("s_waitcnt lgkmcnt(0)":::"memory");SBAR();
    #define PK(k) (bf16x8){lo[k][0],lo[k][1],lo[k][2],lo[k][3],hi[k][0],hi[k][1],hi[k][2],hi[k][3]}
    o[d0]=__builtin_amdgcn_mfma_f32_32x32x16_bf16(pa0,PK(0),o[d0],0,0,0);
    o[d0]=__builtin_amdgcn_mfma_f32_32x32x16_bf16(pa1,PK(1),o[d0],0,0,0);
    o[d0]=__builtin_amdgcn_mfma_f32_32x32x16_bf16(pa2,PK(2),o[d0],0,0,0);
    o[d0]=__builtin_amdgcn_mfma_f32_32x32x16_bf16(pa3,PK(3),o[d0],0,0,0);
    #undef PK
  }
}

#ifndef ATTN_STORE16
#define ATTN_STORE16(p,v) (*(u32x4*)(p)=(v))
#endif
template<int THRL> __device__ __forceinline__ void attn_unit(int b,int h,int qb,const bf16*Q,const bf16*__restrict__ K,const bf16*__restrict__ V,bf16*O,char*shm){
  int tid_=threadIdx.x; asm volatile("":"+v"(tid_)); const int tid=tid_,lane=tid&63,r32=lane&31,hi=lane>>5; const int wid=__builtin_amdgcn_readfirstlane(tid>>6);
  const long rowbase=(long)b*SEQ; const int q0=qb*QB;
  const bf16*Qw=Q+(rowbase+q0+wid*QBLK)*DM+h*D;
  const bf16*Kh=K+rowbase*DM+(h>>2)*D,*Vh=V+rowbase*DM+(h>>2)*D;
  const unsigned lds0=(unsigned)(uintptr_t)shm;
  float*wsf=(float*)(shm+LDS_WS)+wid*64;
  const bf16*ksrc=Kh+(long)lane*DM+wid*8;
  const bf16*vsrc=Vh+(long)(16*(wid&3)+(lane>>2))*DM+(wid>>2)*32+(lane&3)*8;
  const unsigned kdst=lds0+LDS_K+wid*1024, vdst=lds0+LDS_V+wid*1024;
  #define DMA_K(t,slot) glds16(ksrc+(long)(t)*KVBLK*DM,(unsigned)__builtin_amdgcn_readfirstlane(kdst+(slot)))
  #define DMA_V(t,slot) glds16(vsrc+(long)(t)*KVBLK*DM,(unsigned)__builtin_amdgcn_readfirstlane(vdst+(slot)))
  const int vb0=(int)(lds0+LDS_V)+((lane>>4)&1)*32+(lane&3)*8+(4*hi+((lane&15)>>2))*64;
  const char*Kbase=shm+LDS_K; bf16x8 kf[8];
  const lds_cptr shm3=(lds_cptr)shm; const lds_cptr kp0=shm3+LDS_K+hi*1024+r32*16; const lds_cptr vp0=shm3+LDS_V+((lane>>4)&1)*32+(lane&3)*8+(4*hi+((lane&15)>>2))*64;
  constexpr int NT=SEQ/KVBLK;
  DMA_K(0,0);DMA_V(0,0);DMA_K(1,SLOTB);
  bf16x8 qr[4];
  #pragma unroll
  for(int d0=0;d0<4;++d0)qr[d0]=*reinterpret_cast<const bf16x8*>(&Qw[(long)r32*DM+d0*16+hi*8]);
  float mhat=0.f,l_reg=0.f;f32x16 o[2];o[0]=f32x16{};o[1]=f32x16{};f32x16 negm=f32x16{};asm volatile("":"+v"(negm));
  const int qrel=wid*QBLK+r32;
  #define CMASK(P0,P1,t) do{}while(0)
  bool resc=false;
  #define START(P0,P1) do{ resc=false; \
    _Pragma("unroll") for(int r=0;r<16;++r)P0[r]=__builtin_amdgcn_exp2f(P0[r]); }while(0)
  #define RESC() do{ if(resc){ asm volatile("s_waitcnt lgkmcnt(0)":::"memory"); \
      _Pragma("unroll") for(int d_=0;d_<2;++d_) _Pragma("unroll") for(int r=0;r<16;++r)o[d_][r]*=wsf[crow(r,hi)]; } }while(0)
  f32x16 pA0,pA1,pB0,pB1;
  int sl_prev=0,sl_cur=0,sl_next=SLOTB;
  #define ROT() do{sl_prev=sl_cur;sl_cur=sl_next;sl_next=(sl_next==(NSLOT-1)*SLOTB)?0:sl_next+SLOTB;}while(0)
  DMA_K(2,2*SLOTB);
  WAIT_BAR(3);
  qkt(pA0,pA1,Kbase,qr,negm,r32,hi);asm volatile("s_nop 15\n\ts_nop 7":"+v"(pA0),"+v"(pA1));CMASK(pA0,pA1,0);
  START(pA0,pA1);
  _Pragma("unroll") for(int r=0;r<16;++r)pA1[r]=__builtin_amdgcn_exp2f(pA1[r]);
  WAIT_BAR(0);
  DMA_K(3,0);DMA_V(1,SLOTB);
  ROT();
  kload8(kf,kp0+sl_cur);
  WAIT_BAR(2);
  s16x4 vlo[8],vhi[8]; u32x4 pw0,pw1,pw2,pw3;
  #define PKW(P,B) cvtpk_s(P[B],P[B+1])
  #define PAF(k) __builtin_bit_cast(bf16x8,pw##k)
  #define VFR(i) (bf16x8){vlo[i][0],vlo[i][1],vlo[i][2],vlo[i][3],vhi[i][0],vhi[i][1],vhi[i][2],vhi[i][3]}
  #define PIN(x) asm volatile("":"+v"(x))
  #define MX3(a,b,c) __builtin_fmaxf(__builtin_fmaxf((a),(b)),(c))
  #define GAPA(MF,A0,A1,A2,A3,W0,W1,PW) do{ MF; sacc+=A0; sacc+=A1; sacc+=A2; sacc+=A3; PIN(sacc); W0; W1; PIN(PW); SBAR(); }while(0)
  #define EX(v) __builtin_amdgcn_exp2f(v)
  #define GAPB(MF,X,B) do{ MF; X[B]=EX(X[B]); X[B+1]=EX(X[B+1]); X[B+2]=EX(X[B+2]); X[B+3]=EX(X[B+3]); PIN(X); SBAR(); }while(0)
  #define VRD(i) do{ vlo[i]=vtr(vp_+(((i)>>2)*4096+((i)&3)*1024)); vhi[i]=vtr(vp_+(((i)>>2)*4096+((i)&3)*1024+512)); }while(0)
  #define KRD(G,j) do{ if(G){ kload2(kf,kp0+sl_next,j); SBAR(); } }while(0)
  #define STEP(C0,C1,P0,P1,t,GK,GV,GL) do{ SBAR(); \
    const lds_cptr vp_=vp0+sl_prev; \
    VRD(0); SBAR(); float sacc=(P0[0]+P0[1]); \
    GAPA(C0=__builtin_amdgcn_mfma_f32_32x32x16_bf16(kf[0],qr[0],negm,0,0,0), P0[2],P0[3],P0[4],P0[5],     pw0[0]=PKW(P0,0), pw0[1]=PKW(P0,2), pw0); \
    VRD(4); SBAR(); GAPA(C1=__builtin_amdgcn_mfma_f32_32x32x16_bf16(kf[1],qr[0],negm,0,0,0), P0[6],P0[7],P0[8],P0[9],     pw0[2]=PKW(P0,4), pw0[3]=PKW(P0,6), pw0); \
    VRD(1); SBAR(); GAPA(C0=__builtin_amdgcn_mfma_f32_32x32x16_bf16(kf[2],qr[1],C0,0,0,0),   P0[10],P0[11],P0[12],P0[13], pw1[0]=PKW(P0,8), pw1[1]=PKW(P0,10), pw1); \
    VRD(5); SBAR(); GAPA(C1=__builtin_amdgcn_mfma_f32_32x32x16_bf16(kf[3],qr[1],C1,0,0,0),   P0[14],P0[15],P1[0],P1[1],   pw1[2]=PKW(P0,12),pw1[3]=PKW(P0,14), pw1); \
    VRD(2); SBAR(); GAPA(C0=__builtin_amdgcn_mfma_f32_32x32x16_bf16(kf[4],qr[2],C0,0,0,0),   P1[2],P1[3],P1[4],P1[5],     pw2[0]=PKW(P1,0), pw2[1]=PKW(P1,2), pw2); \
    VRD(6); SBAR(); GAPA(C1=__builtin_amdgcn_mfma_f32_32x32x16_bf16(kf[5],qr[2],C1,0,0,0),   P1[6],P1[7],P1[8],P1[9],     pw2[2]=PKW(P1,4), pw2[3]=PKW(P1,6), pw2); \
    VRD(3); SBAR(); GAPA(C0=__builtin_amdgcn_mfma_f32_32x32x16_bf16(kf[6],qr[3],C0,0,0,0),   P1[10],P1[11],P1[12],P1[13], pw3[0]=PKW(P1,8), pw3[1]=PKW(P1,10), pw3); \
    VRD(7); SBAR(); GAPA(C1=__builtin_amdgcn_mfma_f32_32x32x16_bf16(kf[7],qr[3],C1,0,0,0),   P1[14],P1[15],0.f,0.f,       pw3[2]=PKW(P1,12),pw3[3]=PKW(P1,14), pw3); \
    l_reg+=sacc; \
    if(GK){DMA_K((t)+3,sl_cur);} if(GV){DMA_V((t)+1,sl_next);} \
    CMASK(C0,C1,t); \
    resc=false; \
    SBAR(); \
    GAPB(o[0]=__builtin_amdgcn_mfma_f32_32x32x16_bf16(PAF(0),VFR(0),o[0],0,0,0), C0,0); \
    GAPB(o[1]=__builtin_amdgcn_mfma_f32_32x32x16_bf16(PAF(0),VFR(4),o[1],0,0,0), C0,4); \
    KRD(GL,0); GAPB(o[0]=__builtin_amdgcn_mfma_f32_32x32x16_bf16(PAF(1),VFR(1),o[0],0,0,0), C0,8); \
    KRD(GL,1); GAPB(o[1]=__builtin_amdgcn_mfma_f32_32x32x16_bf16(PAF(1),VFR(5),o[1],0,0,0), C0,12); \
    KRD(GL,2); GAPB(o[0]=__builtin_amdgcn_mfma_f32_32x32x16_bf16(PAF(2),VFR(2),o[0],0,0,0), C1,0); \
    KRD(GL,3); GAPB(o[1]=__builtin_amdgcn_mfma_f32_32x32x16_bf16(PAF(2),VFR(6),o[1],0,0,0), C1,4); \
    GAPB(o[0]=__builtin_amdgcn_mfma_f32_32x32x16_bf16(PAF(3),VFR(3),o[0],0,0,0), C1,8); \
    GAPB(o[1]=__builtin_amdgcn_mfma_f32_32x32x16_bf16(PAF(3),VFR(7),o[1],0,0,0), C1,12); \
    }while(0)
  int t=1;
  #undef CMASK
  #define CMASK(P0,P1,t) do{}while(0)
  for(;t+5<NT;t+=2){
    STEP(pB0,pB1,pA0,pA1,t,true,true,true);     WAIT_BAR(2); RESC(); ROT();
    STEP(pA0,pA1,pB0,pB1,t+1,true,true,true);   WAIT_BAR(2); RESC(); ROT();
  }
  #undef CMASK
  #define CMASK(P0,P1,t) do{}while(0)
  #define ENDW(tt) do{ if((tt)+3<NT){WAIT_BAR(2);} else if((tt)+2<NT){WAIT_BAR(1);} else {WAIT_BAR(0);} }while(0)
  for(;t+1<NT;t+=2){
    STEP(pB0,pB1,pA0,pA1,t,(t+3<NT),(t+1<NT),(t+1<NT));       ENDW(t);   RESC(); ROT();
    STEP(pA0,pA1,pB0,pB1,t+1,(t+4<NT),(t+2<NT),(t+2<NT));     ENDW(t+1); RESC(); ROT();
  }
  STEP(pB0,pB1,pA0,pA1,NT-1,false,false,false); RESC();
  { float sacc=pB0[0]+pB0[1]; _Pragma("unroll") for(int r=2;r<16;++r)sacc+=pB0[r]; _Pragma("unroll") for(int r=0;r<16;++r)sacc+=pB1[r]; l_reg+=sacc;
    pw0=(u32x4){PKW(pB0,0),PKW(pB0,2),PKW(pB0,4),PKW(pB0,6)};pw1=(u32x4){PKW(pB0,8),PKW(pB0,10),PKW(pB0,12),PKW(pB0,14)};pw2=(u32x4){PKW(pB1,0),PKW(pB1,2),PKW(pB1,4),PKW(pB1,6)};pw3=(u32x4){PKW(pB1,8),PKW(pB1,10),PKW(pB1,12),PKW(pB1,14)};
    SBAR(); pv(o,vb0+sl_cur,PAF(0),PAF(1),PAF(2),PAF(3)); }
  #undef PKW
  #undef PAF
  #undef VFR
  #undef PIN
  #undef MX3
  #undef GAPA
  #undef GAPB
  #undef EX
  #undef VRD
  #undef KRD
  #undef STEP
  #undef ENDW
  {auto rr=__builtin_amdgcn_permlane32_swap(__float_as_uint(l_reg),__float_as_uint(l_reg),false,false);l_reg=__uint_as_float(rr[0])+__uint_as_float(rr[1]);}
  if(hi==0)wsf[32+r32]=l_reg;asm volatile("s_waitcnt lgkmcnt(0)":::"memory");
  float rli[16];
  #pragma unroll
  for(int r=0;r<16;++r)rli[r]=__builtin_amdgcn_rcpf(wsf[32+crow(r,hi)]);
  bf16*Ow=O+(rowbase+q0+wid*QBLK)*DM+h*D;
  { bf16*stg=(bf16*)(shm+LDS_OST)+wid*2048;
    #pragma unroll
    for(int r=0;r<16;++r){const int orow=crow(r,hi);
      #pragma unroll
      for(int d0=0;d0<2;++d0)stg[orow*64+d0*32+r32]=__float2bfloat16(o[d0][r]*rli[r]);}
    asm volatile("s_waitcnt lgkmcnt(0)":::"memory");
    #pragma unroll
    for(int i=0;i<4;++i){const int row=i*8+(lane>>3),ch=lane&7; const u32x4 v=*(const u32x4*)(stg+row*64+ch*8); ATTN_STORE16(Ow+(long)row*DM+ch*8,v);} }
  asm volatile("s_waitcnt lgkmcnt(0)\n\ts_barrier":::"memory");
  #undef DMA_K
  #undef DMA_V
  #undef CMASK
  #undef START
  #undef RESC
  #undef ROT
}
constexpr int ATTN_LDS_BYTES=LDS_BYTES;
#undef SBAR
#undef WAIT_BAR
}
#define GAS __attribute__((address_space(1)))
#define LAS __attribute__((address_space(3)))
typedef unsigned short bf16;
typedef unsigned v4u __attribute__((ext_vector_type(4)));
typedef unsigned v2u __attribute__((ext_vector_type(2)));
typedef float f32x4 __attribute__((ext_vector_type(4)));
typedef float f32x2 __attribute__((ext_vector_type(2)));
typedef short bf16x8 __attribute__((ext_vector_type(8)));
constexpr int NWAVES = 8, NTHREADS = 512;
constexpr int NB = 6, T = 8192, D = 1024, FF = 4096, M = NB * T;
constexpr int MPROMPT = 2 * T;
constexpr size_t MiB = 1u << 20;
constexpr size_t WS_WIN = 1 * MiB, WS_WOUT = 7 * MiB, WS_WGLU = 9 * MiB, WS_WUP = 11 * MiB, WS_WDN = 19 * MiB, WS_WLORA = 27 * MiB, WS_LBIAS = 28 * MiB + 512 * 1024;
constexpr size_t WS_XN = 29 * MiB, WS_HID = 125 * MiB, WS_END = 509 * MiB;
constexpr size_t WS_R = 29 * MiB, WS_K = 77 * MiB, WS_QKV = 125 * MiB, WS_V = 245 * MiB, WS_YF = 293 * MiB, WS_YB = 341 * MiB, WS_A2 = 389 * MiB;
constexpr size_t WS_E = 125 * MiB, WS_CIN = 173 * MiB, WS_Z = 221 * MiB;
constexpr int LDS_BYTES = 147456, LDS_QWORD = 147392;
constexpr size_t WS_CTL = 0, WS_BAR = 65536;
constexpr int LDS_BARST = 147400;
constexpr size_t WS_ROWSQ = 262144;
constexpr int NIN = 2816, NLORA = 2048, KLORA = 384;

__device__ __forceinline__ float bf_lo(unsigned w) { return __uint_as_float(w << 16); }
__device__ __forceinline__ float bf_hi(unsigned w) { return __uint_as_float(w & 0xffff0000u); }
__device__ __forceinline__ float bf1(bf16 b) { return __uint_as_float((unsigned)b << 16); }
__device__ __forceinline__ unsigned pk2(float lo, float hi) { return pg8::cvt_pk_bf16(lo, hi); }
__device__ __forceinline__ void unpack8(const v4u w, float* f) { f[0] = bf_lo(w.x); f[1] = bf_hi(w.x); f[2] = bf_lo(w.y); f[3] = bf_hi(w.y); f[4] = bf_lo(w.z); f[5] = bf_hi(w.z); f[6] = bf_lo(w.w); f[7] = bf_hi(w.w); }
__device__ __forceinline__ v4u pack8f(const float* f) { v4u w; w.x = pk2(f[0], f[1]); w.y = pk2(f[2], f[3]); w.z = pk2(f[4], f[5]); w.w = pk2(f[6], f[7]); return w; }
__device__ __forceinline__ float fsig(float x) { return __builtin_amdgcn_rcpf(1.0f + __expf(-x)); }
__device__ __forceinline__ float ftanh(float x) { return 1.0f - 2.0f * __builtin_amdgcn_rcpf(1.0f + __expf(2.0f * x)); }
#define LDS_WAIT() asm volatile("s_waitcnt lgkmcnt(0)" ::: "memory")
template <int CTRL> __device__ __forceinline__ float dppf(float v) { return __builtin_bit_cast(float, __builtin_amdgcn_update_dpp(0, __builtin_bit_cast(int, v), CTRL, 0xF, 0xF, true)); }
__device__ __forceinline__ float sum16(float v) { v += dppf<0xB1>(v); v += dppf<0x4E>(v); v += dppf<0x124>(v); v += dppf<0x128>(v); return v; }
__device__ __forceinline__ float sum8(float v) { v += dppf<0xB1>(v); v += dppf<0x4E>(v); v += dppf<0x141>(v); return v; }

#define RLX_AGENT __ATOMIC_RELAXED, __HIP_MEMORY_SCOPE_AGENT
#define XB_TMO      128
#define XB_XCNT(j)  (256  + 64 * (j))
#define XB_XSUB(j)  (1280 + 64 * (j))
#define XB_XGEN(j)  (2304 + 64 * (j))
#define XB_TOP      3328
#define XB_TOPGEN   3392
#define XCD_BAR_WORDS 3456
#define XB_SPIN_CAP (1u << 18)

__device__ __forceinline__ unsigned xb_ld(unsigned* p)              { return __hip_atomic_load(p, __ATOMIC_RELAXED, __HIP_MEMORY_SCOPE_AGENT); }
__device__ __forceinline__ unsigned xb_add(unsigned* p, unsigned v) { return __hip_atomic_fetch_add(p, v, __ATOMIC_RELAXED, __HIP_MEMORY_SCOPE_AGENT); }
__device__ __forceinline__ unsigned xb_xcc_id() { return (unsigned)__builtin_amdgcn_s_getreg((3 << 11) | 20) & 0xFu; }
#define XB_SPIN(cond, bar) do { unsigned _sp = 0; while (cond) { __builtin_amdgcn_s_sleep(1); \
    if ((++_sp & 255u) == 0u) { if (xb_ld(&(bar)[XB_TMO])) break; if (_sp > XB_SPIN_CAP) { atomicAdd(&(bar)[XB_TMO], 1u); break; } } } } while (0)

struct XcdBarrier {
    unsigned* bar; unsigned x;
    volatile LAS unsigned* st;
};

__device__ __forceinline__ XcdBarrier xcd_barrier_post(unsigned* bar, volatile LAS unsigned* st) {
    XcdBarrier b; b.bar = bar; b.x = xb_xcc_id(); b.st = st;
    if (threadIdx.x == 0) (void)xb_add(&bar[XB_XCNT(b.x)], 1u);
    return b;
}
__device__ __forceinline__ void xcd_barrier_complete(unsigned* bar, unsigned x, unsigned& nloc, unsigned& nx) {
    const unsigned G = gridDim.x * gridDim.y * gridDim.z;
    unsigned sum, cnt, mine, sp = 0u;
    for (;;) {
        sum = 0u; cnt = 0u; mine = 0u;
#pragma unroll
        for (unsigned j = 0; j < 16; ++j) { const unsigned c = xb_ld(&bar[XB_XCNT(j)]); sum += c; cnt += (c > 0u) ? 1u : 0u; mine = (j == x) ? c : mine; }
        if (sum == G) break;
        __builtin_amdgcn_s_sleep(1);
        if ((++sp & 255u) == 0u) { if (xb_ld(&bar[XB_TMO])) break; if (sp > XB_SPIN_CAP) { atomicAdd(&bar[XB_TMO], 1u); break; } }
    }
    nloc = mine > 0u ? mine : 1u; nx = cnt > 0u ? cnt : 1u;
}

__device__ __forceinline__ void xcd_barrier(const XcdBarrier& b) {
    asm volatile("s_waitcnt vmcnt(0)" ::: "memory");
    __syncthreads();
    if (threadIdx.x == 0) {
        unsigned* bar = b.bar;
        __builtin_amdgcn_s_waitcnt(0);
        unsigned nloc = b.st[0], nx = b.st[1];
        if (nloc == 0u) { xcd_barrier_complete(bar, b.x, nloc, nx); b.st[0] = nloc; b.st[1] = nx; }
        const unsigned old = xb_add(&bar[XB_XSUB(b.x)], 1u);
        const unsigned gen = old / nloc;
        if (old + 1u == (gen + 1u) * nloc) {
            __builtin_amdgcn_fence(__ATOMIC_RELEASE, "agent");
            asm volatile("s_waitcnt vmcnt(0)" ::: "memory");
            const unsigned og = xb_add(&bar[XB_TOP], 1u);
            const unsigned tg = og / nx;
            if (og + 1u == (tg + 1u) * nx) xb_add(&bar[XB_TOPGEN], 1u);
            else XB_SPIN(xb_ld(&bar[XB_TOPGEN]) == tg, bar);
            __builtin_amdgcn_fence(__ATOMIC_ACQUIRE, "agent");
            xb_add(&bar[XB_XGEN(b.x)], 1u);
            asm volatile("s_waitcnt vmcnt(0)" ::: "memory");
        } else {
            XB_SPIN(xb_ld(&bar[XB_XGEN(b.x)]) == gen, bar);
            __builtin_amdgcn_fence(__ATOMIC_ACQUIRE, "agent");
            asm volatile("s_waitcnt vmcnt(0)" ::: "memory");
        }
    }
    __syncthreads();
}


struct Args { const float* in[38]; float* out; unsigned char* ws; int pad0, pad1; };

__device__ __forceinline__ void transpose_item(const float* W, int N, bf16* WT, int ldt, int k0, int n0, int drow0, LAS float* scr, int lane, const float* gain = nullptr) {
#pragma unroll 8
    for (int i = 0; i < 32; ++i) { const int kk = 2 * i + (lane >> 5); float wv = W[(size_t)(k0 + kk) * N + n0 + (lane & 31)]; if (gain) wv *= gain[k0 + kk]; scr[kk * 33 + (lane & 31)] = wv; }
    LDS_WAIT();
    const int c = lane & 7;
#pragma unroll
    for (int j = 0; j < 4; ++j) { const int n = (lane >> 3) + 8 * j; const LAS float* s = scr + (8 * c) * 33 + n;
        v4u o; o.x = pk2(s[0 * 33], s[1 * 33]); o.y = pk2(s[2 * 33], s[3 * 33]); o.z = pk2(s[4 * 33], s[5 * 33]); o.w = pk2(s[6 * 33], s[7 * 33]);
        *(v4u*)(WT + (size_t)(drow0 + n) * ldt + k0 + 8 * c) = o; }
    LDS_WAIT();
}
__device__ __forceinline__ void transpose_matrix(const float* W, int K, int N, bf16* WT, LAS float* scr, int gw, int NGW, int lane, const float* gain = nullptr) {
    const int nblk = N / 32, nit = (K / 64) * nblk;
    for (int it = gw; it < nit; it += NGW) { const int kb = it / nblk, nb = it % nblk; transpose_item(W, N, WT, K, 64 * kb, 32 * nb, 32 * nb, scr, lane, gain); }
}
__device__ __forceinline__ float wave_sum(float v) {
#pragma unroll
    for (int o = 1; o < 64; o <<= 1) v += __shfl_xor(v, o);
    return v;
}
template <int R>
__device__ __forceinline__ void rms_rows(const float* const (&xrow)[R], const float* gain, bf16* const (&orow)[R], int lane) {
    f32x4 v[R][4]; float s[R];
#pragma unroll
    for (int r = 0; r < R; ++r) { const f32x4* xr = (const f32x4*)xrow[r] + lane;
#pragma unroll
        for (int j = 0; j < 4; ++j) v[r][j] = __builtin_nontemporal_load(&xr[64 * j]); }
    const f32x4* gr = (const f32x4*)gain + lane;
    f32x4 g[4];
#pragma unroll
    for (int j = 0; j < 4; ++j) g[j] = gr[64 * j];
    asm volatile("s_waitcnt vmcnt(0)" ::: "memory");
#pragma unroll
    for (int r = 0; r < R; ++r) { s[r] = 0.f;
#pragma unroll
        for (int j = 0; j < 4; ++j) s[r] += (v[r][j].x * v[r][j].x + v[r][j].y * v[r][j].y) + (v[r][j].z * v[r][j].z + v[r][j].w * v[r][j].w); }
#pragma unroll
    for (int o = 1; o < 64; o <<= 1) {
#pragma unroll
        for (int r = 0; r < R; ++r) s[r] += __shfl_xor(s[r], o); }
#pragma unroll
    for (int r = 0; r < R; ++r) { const float rs = 1.0f / sqrtf(s[r] * (1.f / 1024.f) + 1e-6f); v2u* o8 = (v2u*)orow[r] + lane;
#pragma unroll
        for (int j = 0; j < 4; ++j) { v2u w; w.x = pk2(v[r][j].x * rs * g[j].x, v[r][j].y * rs * g[j].y); w.y = pk2(v[r][j].z * rs * g[j].z, v[r][j].w * rs * g[j].w); o8[64 * j] = w; } }
}
__device__ __forceinline__ void rms_all(const float* xa, const float* xb, int split, const float* gain, bf16* XN, int gw, int NGW, int lane) {
    for (int m0 = gw * 4; m0 < M; m0 += NGW * 4) { const float* xr[4]; bf16* orow[4];
#pragma unroll
        for (int r = 0; r < 4; ++r) { const int m = m0 + r; xr[r] = (m < split) ? xa + (size_t)m * D : xb + (size_t)(m - split) * D; orow[r] = XN + (size_t)m * D; }
        rms_rows<4>(xr, gain, orow, lane); }
}
__device__ __forceinline__ void phase_shift_qk(const Args& a, int gw, int NGW, int lane) {
    const bf16* HR = (const bf16*)a.out;
    bf16* Rb = (bf16*)(a.ws + WS_R); bf16* Kb = (bf16*)(a.ws + WS_K); bf16* Vb = (bf16*)(a.ws + WS_V); bf16* A2 = (bf16*)(a.ws + WS_A2);
    bf16* QKV = (bf16*)(a.ws + WS_QKV);
    const float* mu = a.in[7]; const float* qn = a.in[20]; const float* kn = a.in[21];
    const int p = lane & 31, half = lane >> 5;
    const float invf = exp2f(-(float)(p & 15) * (13.287712379549449f / 16.0f)) * 0.15915494309189535f;
    const float gq0 = qn[2 * p], gq1 = qn[2 * p + 1], gk0 = kn[2 * p], gk1 = kn[2 * p + 1];
    for (int tok = gw; tok < M; tok += NGW) {
        const int t = tok & (T - 1);
        const bf16* hrow = HR + (size_t)tok * 2048;
        v4u cc[4], pp[4], nn[4]; unsigned qw5[5];
        bf16* qrow = QKV + (size_t)tok * 1280 + 512;
#pragma unroll
        for (int i = 0; i < 4; ++i) { const int cgp = lane + 64 * i; cc[i] = (v4u){0u, 0u, 0u, 0u}; pp[i] = cc[i]; nn[i] = cc[i];
            if (cgp < 232) { const int col = cgp * 8; cc[i] = *(const v4u*)(hrow + col); if (t > 0) pp[i] = *(const v4u*)(hrow - 2048 + col); if (t < T - 1) nn[i] = *(const v4u*)(hrow + 2048 + col); } }
#pragma unroll
        for (int i = 0; i < 5; ++i) qw5[i] = *(const unsigned*)(qrow + (half + 2 * i) * 64 + 2 * p);
        asm volatile("s_waitcnt vmcnt(0)" ::: "memory");
#pragma unroll
        for (int i = 0; i < 4; ++i) { const int cgp = lane + 64 * i;
            if (cgp < 232) { const int col = cgp * 8;
                const v4u c = cc[i], pv = pp[i], nv = nn[i];
                const f32x4 m0 = *(const f32x4*)(mu + col), m1 = *(const f32x4*)(mu + col + 4);
                float h[8], pf[8], nf[8], hs[8]; unpack8(c, h); unpack8(pv, pf); unpack8(nv, nf);
#pragma unroll
                for (int j = 0; j < 8; ++j) { const float mj = j < 4 ? m0[j] : m1[j - 4]; hs[j] = h[j] + mj * (0.5f * (pf[j] + nf[j]) - h[j]); }
                if (col < 1536) { bf16* dst = (col < 512 ? Rb : (col < 1024 ? Kb : Vb)) + (size_t)tok * 512 + (col & 511); *(v4u*)dst = pack8f(hs); }
                else { const int c2 = col - 1536;
                    if (c2 < 128) {
#pragma unroll
                        for (int j = 0; j < 8; ++j) hs[j] = ftanh(hs[j]); }
                    else if (c2 >= 192) {
#pragma unroll
                        for (int j = 0; j < 8; ++j) hs[j] = fsig(hs[j]); }
                    *(v4u*)(A2 + (size_t)tok * KLORA + c2) = pack8f(hs); } } }
        if (lane < 8) *(v4u*)(A2 + (size_t)tok * KLORA + 320 + lane * 8) = (v4u){0u, 0u, 0u, 0u};
        const float pos = (float)(p < 16 ? (t >> 6) : (t & 63));
        const float rev = __builtin_amdgcn_fractf(pos * invf);
        const float sn = __builtin_amdgcn_sinf(rev), cs = __builtin_amdgcn_cosf(rev);
#pragma unroll
        for (int i = 0; i < 5; ++i) { const int hh = half + 2 * i;
            const unsigned w = qw5[i];
            const float x1 = bf_lo(w), x2 = bf_hi(w);
            float ss = x1 * x1 + x2 * x2;
            ss += __shfl_xor(ss, 1); ss += __shfl_xor(ss, 2); ss += __shfl_xor(ss, 4); ss += __shfl_xor(ss, 8); ss += __shfl_xor(ss, 16);
            const float rs = 1.0f / sqrtf(ss * (1.f / 64.f) + 1e-6f);
            const bool isq = hh < 8;
            const float y1 = x1 * rs * (isq ? gq0 : gk0), y2 = x2 * rs * (isq ? gq1 : gk1);
            float o1 = y1 * cs - y2 * sn, o2 = y1 * sn + y2 * cs;
            if (isq) { o1 *= attn_body::C2; o2 *= attn_body::C2; }
            *(unsigned*)(qrow + hh * 64 + 2 * p) = pk2(o1, o2); }
    }
}

constexpr int RW_TC = 32, RW_ARR = RW_TC * 64, RW_BUF = 6 * RW_ARR, RW_NCH = T / RW_TC;
__device__ __forceinline__ void rwkv_chain(const Args& a, LAS unsigned char* lds, int chain2, int tid, int wave, int lane) {
    const int chain = chain2 >> 1, half = chain2 & 1;
    const int b = chain >> 4, h = (chain >> 1) & 7, dir = chain & 1;
    LAS float* buf = (LAS float*)lds;
    if (wave >= 4) {
        const bf16* Rb = (const bf16*)(a.ws + WS_R); const bf16* Kb = (const bf16*)(a.ws + WS_K); const bf16* Vb = (const bf16*)(a.ws + WS_V);
        const bf16* Ab = (const bf16*)a.out + (size_t)2 * M * 512; const bf16* Db = (const bf16*)a.out + (size_t)dir * M * 512;
        const int ltid = tid - 256, ls = ltid >> 3, lc = (ltid & 7) * 8;
        const size_t gbase = (size_t)b * T * 512 + h * 64 + lc;
        float kk8[8], ka8[8];
#pragma unroll
        for (int j = 0; j < 8; ++j) { kk8[j] = a.in[15][h * 64 + lc + j]; ka8[j] = a.in[16][h * 64 + lc + j]; }
        v4u rR, rK, rV, rA, rD;
#define RW_LOAD(c) do { int t_ = (c) * RW_TC + ls; if (dir) t_ = T - 1 - t_; const size_t o_ = gbase + (size_t)t_ * 512; \
        rR = *(const v4u*)(Rb + o_); rK = *(const v4u*)(Kb + o_); rV = *(const v4u*)(Vb + o_); rA = *(const v4u*)(Ab + o_); rD = *(const v4u*)(Db + o_); } while (0)
#define RW_STAGE(c) do { LAS float* B_ = buf + ((c) & 1) * RW_BUF + ls * 64 + lc; \
        float r8[8], k8[8], v8[8], a8[8], d8[8], n8[8]; unpack8(rR, r8); unpack8(rK, k8); unpack8(rV, v8); unpack8(rA, a8); unpack8(rD, d8); \
        float ss_ = 0.f; _Pragma("unroll") for (int j = 0; j < 8; ++j) { n8[j] = k8[j] * kk8[j]; ss_ += n8[j] * n8[j]; } \
        ss_ = sum8(ss_); const float inv_ = 1.0f / fmaxf(sqrtf(ss_), 1e-12f); \
        f32x4 o0, o1; \
        _Pragma("unroll") for (int j = 0; j < 4; ++j) { o0[j] = -n8[j] * inv_; o1[j] = -n8[4 + j] * inv_; } *(LAS f32x4*)(B_ + 0 * RW_ARR) = o0; *(LAS f32x4*)(B_ + 0 * RW_ARR + 4) = o1; \
        _Pragma("unroll") for (int j = 0; j < 4; ++j) { o0[j] = n8[j] * inv_ * a8[j]; o1[j] = n8[4 + j] * inv_ * a8[4 + j]; } *(LAS f32x4*)(B_ + 1 * RW_ARR) = o0; *(LAS f32x4*)(B_ + 1 * RW_ARR + 4) = o1; \
        _Pragma("unroll") for (int j = 0; j < 4; ++j) { o0[j] = __expf(-d8[j]); o1[j] = __expf(-d8[4 + j]); } *(LAS f32x4*)(B_ + 2 * RW_ARR) = o0; *(LAS f32x4*)(B_ + 2 * RW_ARR + 4) = o1; \
        _Pragma("unroll") for (int j = 0; j < 4; ++j) { o0[j] = k8[j] * (1.0f + (a8[j] - 1.0f) * ka8[j]); o1[j] = k8[4 + j] * (1.0f + (a8[4 + j] - 1.0f) * ka8[4 + j]); } *(LAS f32x4*)(B_ + 3 * RW_ARR) = o0; *(LAS f32x4*)(B_ + 3 * RW_ARR + 4) = o1; \
        _Pragma("unroll") for (int j = 0; j < 4; ++j) { o0[j] = r8[j]; o1[j] = r8[4 + j]; } *(LAS f32x4*)(B_ + 4 * RW_ARR) = o0; *(LAS f32x4*)(B_ + 4 * RW_ARR + 4) = o1; \
        _Pragma("unroll") for (int j = 0; j < 4; ++j) { o0[j] = v8[j]; o1[j] = v8[4 + j]; } *(LAS f32x4*)(B_ + 5 * RW_ARR) = o0; *(LAS f32x4*)(B_ + 5 * RW_ARR + 4) = o1; } while (0)
        RW_LOAD(0); RW_STAGE(0); RW_LOAD(1);
        __syncthreads();
        for (int c = 0; c < RW_NCH; ++c) {
            if (c + 1 < RW_NCH) { RW_STAGE(c + 1); if (c + 2 < RW_NCH) RW_LOAD(c + 2); }
            __syncthreads();
        }
#undef RW_LOAD
#undef RW_STAGE
    } else {
        bf16* Yb = (bf16*)(a.ws + (dir ? WS_YB : WS_YF));
        LAS float* yst = (LAS float*)(lds + 2 * RW_BUF * 4) + wave * 256;
        const int r8 = lane >> 3, ks = (lane & 7) * 8;
        f32x2 S0[4];
#pragma unroll
        for (int i = 0; i < 4; ++i) S0[i] = (f32x2){0.f, 0.f};
        __syncthreads();
        for (int c = 0; c < RW_NCH; ++c) {
            const LAS float* Bk = buf + (c & 1) * RW_BUF + ks; const LAS float* Bv = buf + (c & 1) * RW_BUF + 5 * RW_ARR + half * 32 + wave * 8 + r8;
            f32x4 na0 = *(const LAS f32x4*)(Bk + 0 * RW_ARR), na1 = *(const LAS f32x4*)(Bk + 0 * RW_ARR + 4), nb0 = *(const LAS f32x4*)(Bk + 1 * RW_ARR), nb1 = *(const LAS f32x4*)(Bk + 1 * RW_ARR + 4);
            f32x4 nw0 = *(const LAS f32x4*)(Bk + 2 * RW_ARR), nw1 = *(const LAS f32x4*)(Bk + 2 * RW_ARR + 4), nk0 = *(const LAS f32x4*)(Bk + 3 * RW_ARR), nk1 = *(const LAS f32x4*)(Bk + 3 * RW_ARR + 4);
            f32x4 nr0 = *(const LAS f32x4*)(Bk + 4 * RW_ARR), nr1 = *(const LAS f32x4*)(Bk + 4 * RW_ARR + 4); float nvv = *Bv;
#pragma unroll 2
            for (int s = 0; s < RW_TC; ++s) {
                const f32x4 a0 = na0, a1 = na1, b0 = nb0, b1 = nb1, w0 = nw0, w1 = nw1, k0 = nk0, k1 = nk1, r0 = nr0, r1 = nr1; const float vv = nvv;
                { const int sn = (s + 1 < RW_TC) ? s + 1 : s; const LAS float* Bs = Bk + sn * 64;
                  na0 = *(const LAS f32x4*)(Bs + 0 * RW_ARR); na1 = *(const LAS f32x4*)(Bs + 0 * RW_ARR + 4); nb0 = *(const LAS f32x4*)(Bs + 1 * RW_ARR); nb1 = *(const LAS f32x4*)(Bs + 1 * RW_ARR + 4);
                  nw0 = *(const LAS f32x4*)(Bs + 2 * RW_ARR); nw1 = *(const LAS f32x4*)(Bs + 2 * RW_ARR + 4); nk0 = *(const LAS f32x4*)(Bs + 3 * RW_ARR); nk1 = *(const LAS f32x4*)(Bs + 3 * RW_ARR + 4);
                  nr0 = *(const LAS f32x4*)(Bs + 4 * RW_ARR); nr1 = *(const LAS f32x4*)(Bs + 4 * RW_ARR + 4); nvv = Bv[sn * 64]; }
                const f32x2 av[4] = {{a0.x, a0.y}, {a0.z, a0.w}, {a1.x, a1.y}, {a1.z, a1.w}}, bv[4] = {{b0.x, b0.y}, {b0.z, b0.w}, {b1.x, b1.y}, {b1.z, b1.w}};
                const f32x2 wv[4] = {{w0.x, w0.y}, {w0.z, w0.w}, {w1.x, w1.y}, {w1.z, w1.w}}, kv[4] = {{k0.x, k0.y}, {k0.z, k0.w}, {k1.x, k1.y}, {k1.z, k1.w}};
                const f32x2 rv[4] = {{r0.x, r0.y}, {r0.z, r0.w}, {r1.x, r1.y}, {r1.z, r1.w}};
                const f32x2 p0 = (S0[0] * av[0] + S0[1] * av[1]) + (S0[2] * av[2] + S0[3] * av[3]);
                const float sa0 = sum8(p0.x + p0.y);
                const f32x2 v0 = {vv, vv}, s0 = {sa0, sa0};
#pragma unroll
                for (int i = 0; i < 4; ++i) S0[i] = S0[i] * wv[i] + (v0 * kv[i] + s0 * bv[i]);
                const f32x2 q0 = (S0[0] * rv[0] + S0[1] * rv[1]) + (S0[2] * rv[2] + S0[3] * rv[3]);
                const float y0 = sum8(q0.x + q0.y);
                yst[s * 8 + r8] = y0;
            }
            LDS_WAIT();
            if (lane < 32) { const f32x4 y0 = *(const LAS f32x4*)(yst + lane * 8), y1 = *(const LAS f32x4*)(yst + lane * 8 + 4);
                int t_ = c * RW_TC + lane; if (dir) t_ = T - 1 - t_;
                v4u w; w.x = pk2(y0.x, y0.y); w.y = pk2(y0.z, y0.w); w.z = pk2(y1.x, y1.y); w.w = pk2(y1.z, y1.w);
                *(v4u*)(Yb + ((size_t)b * T + t_) * 512 + h * 64 + half * 32 + wave * 8) = w; }
            LDS_WAIT();
            __syncthreads();
        }
    }
    __syncthreads();
}

__device__ __forceinline__ void phase_post(const Args& a, int gw, int NGW, int lane) {
    const bf16* Rb = (const bf16*)(a.ws + WS_R); const bf16* Kb = (const bf16*)(a.ws + WS_K); const bf16* Vb = (const bf16*)(a.ws + WS_V);
    const bf16* Ab = (const bf16*)a.out + (size_t)2 * M * 512; const bf16* Gb = (const bf16*)a.out + (size_t)3 * M * 512;
    const bf16* YF = (const bf16*)(a.ws + WS_YF); const bf16* YB = (const bf16*)(a.ws + WS_YB);
    bf16* QKV = (bf16*)(a.ws + WS_QKV);
    const int ch = lane * 8;
    float ka[8], rk[8], lg[8], lb[8];
#pragma unroll
    for (int j = 0; j < 8; ++j) { ka[j] = a.in[16][ch + j]; rk[j] = a.in[17][ch + j]; lg[j] = a.in[18][ch + j]; lb[j] = a.in[19][ch + j]; }
    for (int tok0 = gw; tok0 < M; tok0 += 2 * NGW) {
        v4u lyf[2], lyb[2], lr[2], lk[2], lv[2], la[2], lgt[2];
#pragma unroll
        for (int u = 0; u < 2; ++u) { const int tok = tok0 + u * NGW; const size_t off = (size_t)(tok < M ? tok : tok0) * 512 + ch;
            lyf[u] = __builtin_nontemporal_load((const v4u*)(YF + off)); lyb[u] = __builtin_nontemporal_load((const v4u*)(YB + off)); lr[u] = __builtin_nontemporal_load((const v4u*)(Rb + off)); lk[u] = __builtin_nontemporal_load((const v4u*)(Kb + off));
            lv[u] = __builtin_nontemporal_load((const v4u*)(Vb + off)); la[u] = __builtin_nontemporal_load((const v4u*)(Ab + off)); lgt[u] = __builtin_nontemporal_load((const v4u*)(Gb + off)); }
        asm volatile("s_waitcnt vmcnt(0)" ::: "memory");
#pragma unroll
        for (int u = 0; u < 2; ++u) { const int tok = tok0 + u * NGW;
            float yf[8], yb[8], r[8], k[8], v[8], aa[8], g[8], o[8];
            unpack8(lyf[u], yf); unpack8(lyb[u], yb); unpack8(lr[u], r); unpack8(lk[u], k); unpack8(lv[u], v); unpack8(la[u], aa); unpack8(lgt[u], g);
            float s = 0.f, bs = 0.f;
#pragma unroll
            for (int j = 0; j < 8; ++j) { yf[j] += yb[j]; s += yf[j]; const float kt = k[j] * (1.0f + (aa[j] - 1.0f) * ka[j]); bs += r[j] * kt * rk[j]; }
            s = sum8(s); bs = sum8(bs);
            const float mean = s * (1.f / 64.f); float q = 0.f;
#pragma unroll
            for (int j = 0; j < 8; ++j) { yf[j] -= mean; q += yf[j] * yf[j]; }
            q = sum8(q);
            const float rstd = 1.0f / sqrtf(q * (1.f / 64.f) + 64e-5f);
#pragma unroll
            for (int j = 0; j < 8; ++j) o[j] = (yf[j] * rstd * lg[j] + lb[j] + bs * v[j]) * g[j];
            if (tok < M) *(v4u*)(QKV + (size_t)tok * 1280 + ch) = pack8f(o); }
    }
}
constexpr int S5_LC = 64, S5_NCH = T / S5_LC, S5_SC = 16;
constexpr int S5_BU_STRIDE = 132, S5_ST_STRIDE = 136, S5_WAVE_LDS = 16 * S5_BU_STRIDE * 4 + 16 * S5_ST_STRIDE * 2;
__device__ __forceinline__ float gelu_tanh(float y) { const float u = 0.7978845608028654f * (y + 0.044715f * y * y * y); return 0.5f * y * (1.0f + ftanh(u)); }
__device__ __forceinline__ void s5_consts(const Args& a, int g, int p, int dir, float& lbr, float& lbi, float& cr, float& ci) {
    const float lr = (dir ? a.in[26] : a.in[23])[g * 64 + p], li = (dir ? a.in[27] : a.in[24])[g * 64 + p], dt = expf((dir ? a.in[28] : a.in[25])[g]);
    const float mag = expf(lr * dt); const float rev = __builtin_amdgcn_fractf(li * dt * 0.15915494309189535f); const float sn = __builtin_amdgcn_sinf(rev), cs = __builtin_amdgcn_cosf(rev);
    lbr = mag * cs; lbi = mag * sn;
    const float nr = lbr - 1.0f, ni = lbi, den = lr * lr + li * li;
    cr = (nr * lr + ni * li) / den; ci = (ni * lr - nr * li) / den;
}
struct S5Ops { bf16x8 Bop[8]; bf16x8 Cop[4]; float lbr, lbi; };
template <int PASS, int DIR>
__device__ __forceinline__ void s5_build(const Args& a, int g, int lane, S5Ops& o) {
    const int n = lane & 15, kq = lane >> 4;
    float cr, ci; s5_consts(a, g, lane, DIR, o.lbr, o.lbi, cr, ci);
#pragma unroll
    for (int q = 0; q < 4; ++q) { const int pp = q * 16 + n;
        const float c_r = __shfl(cr, pp), c_i = __shfl(ci, pp);
        float br[8], bi[8];
        if (kq < 2) { const f32x4 x0 = *(const f32x4*)(a.in[29] + (size_t)(g * 64 + pp) * 16 + kq * 8), x1 = *(const f32x4*)(a.in[29] + (size_t)(g * 64 + pp) * 16 + kq * 8 + 4);
            const f32x4 y0 = *(const f32x4*)(a.in[30] + (size_t)(g * 64 + pp) * 16 + kq * 8), y1 = *(const f32x4*)(a.in[30] + (size_t)(g * 64 + pp) * 16 + kq * 8 + 4);
#pragma unroll
            for (int j = 0; j < 4; ++j) { br[j] = x0[j]; br[4 + j] = x1[j]; bi[j] = y0[j]; bi[4 + j] = y1[j]; } }
        else {
#pragma unroll
            for (int j = 0; j < 8; ++j) { br[j] = 0.f; bi[j] = 0.f; } }
        float vr[8], vi[8];
#pragma unroll
        for (int j = 0; j < 8; ++j) { vr[j] = c_r * br[j] - c_i * bi[j]; vi[j] = c_r * bi[j] + c_i * br[j]; }
        o.Bop[2 * q] = __builtin_bit_cast(bf16x8, pack8f(vr)); o.Bop[2 * q + 1] = __builtin_bit_cast(bf16x8, pack8f(vi)); }
    if (PASS == 2) {
#pragma unroll
        for (int ks = 0; ks < 4; ++ks) { const int k0 = 32 * ks + 8 * kq; const float* src = (k0 < 64) ? ((DIR ? a.in[33] : a.in[31]) + (size_t)(g * 16 + n) * 64 + k0) : ((DIR ? a.in[34] : a.in[32]) + (size_t)(g * 16 + n) * 64 + (k0 - 64));
            const f32x4 x0 = *(const f32x4*)src, x1 = *(const f32x4*)(src + 4); const float sg = (k0 < 64) ? 1.0f : -1.0f; float v[8];
#pragma unroll
            for (int j = 0; j < 4; ++j) { v[j] = sg * x0[j]; v[4 + j] = sg * x1[j]; }
            o.Cop[ks] = __builtin_bit_cast(bf16x8, pack8f(v)); } }
}
template <int PASS, int DIR>
__device__ __forceinline__ void s5_dir(const Args& a, const S5Ops& o, LAS float* bu, LAS bf16* sst, LAS bf16* ust, int tok0, size_t eidx, int g, int lane, const v4u (&araw)[4], f32x2 cin, float dsk, f32x4 (&yf)[4]) {
    bf16* Z = (bf16*)(a.ws + WS_Z); f32x2* E = (f32x2*)(a.ws + WS_E);
    const int n = lane & 15, kq = lane >> 4;
    float sre = 0.f, sim = 0.f;
    if (PASS == 2) { sre = cin.x; sim = cin.y; }
    const int recol = (lane >> 4) * 32 + (lane & 15);
    const float lbr = o.lbr, lbi = o.lbi;
#pragma unroll
    for (int sc = 0; sc < 4; ++sc) { const int sci = DIR ? 3 - sc : sc; const int t0 = tok0 + sci * S5_SC;
        const bf16x8 Aop = __builtin_bit_cast(bf16x8, araw[sci]);
        if (PASS == 2 && DIR == 1 && kq < 2) *(LAS v4u*)(ust + n * 16 + kq * 8) = araw[sci];
        pg8::f32x4 acc[8];
#pragma unroll
        for (int nt = 0; nt < 8; ++nt) acc[nt] = __builtin_amdgcn_mfma_f32_16x16x32_bf16(Aop, o.Bop[nt], (pg8::f32x4){0.f, 0.f, 0.f, 0.f}, 0, 0, 0);
#pragma unroll
        for (int nt = 0; nt < 8; ++nt)
#pragma unroll
            for (int j = 0; j < 4; ++j) bu[(4 * kq + j) * S5_BU_STRIDE + nt * 16 + n] = acc[nt][j];
        LDS_WAIT();
        float bre[16], bim[16];
#pragma unroll
        for (int t = 0; t < 16; ++t) { bre[t] = bu[t * S5_BU_STRIDE + recol]; bim[t] = bu[t * S5_BU_STRIDE + recol + 16]; }
        LDS_WAIT();
        float sr[16], si[16];
#pragma unroll
        for (int tt = 0; tt < 16; ++tt) { const int t = DIR ? 15 - tt : tt;
            const float nre = lbr * sre + (bre[t] - lbi * sim), nim = lbr * sim + (lbi * sre + bim[t]);
            sre = nre; sim = nim; sr[t] = sre; si[t] = sim; }
        if (PASS == 2) {
#pragma unroll
            for (int t = 0; t < 16; ++t) { sst[t * S5_ST_STRIDE + lane] = (bf16)(pk2(sr[t], 0.f) & 0xffffu); sst[t * S5_ST_STRIDE + 64 + lane] = (bf16)(pk2(si[t], 0.f) & 0xffffu); } }
        if (PASS == 2) {
            LDS_WAIT();
            pg8::f32x4 y = (pg8::f32x4){0.f, 0.f, 0.f, 0.f};
#pragma unroll
            for (int ks = 0; ks < 4; ++ks) { const bf16x8 A2 = *(const LAS bf16x8*)(sst + n * S5_ST_STRIDE + ks * 32 + kq * 8); y = __builtin_amdgcn_mfma_f32_16x16x32_bf16(A2, o.Cop[ks], y, 0, 0, 0); }
            if (DIR == 0) { yf[sci] = y; }
            else {
#pragma unroll
                for (int j = 0; j < 4; ++j) { const float uv = bf1(ust[(4 * kq + j) * 16 + n]);
                    const float yy = y[j] + yf[sci][j] + uv * dsk; Z[(size_t)(t0 + 4 * kq + j) * 1024 + g * 16 + n] = (bf16)(pk2(gelu_tanh(yy), 0.f) & 0xffffu); } }
        }
        LDS_WAIT();
    }
    if (PASS == 1) E[eidx] = (f32x2){sre, sim};
}
template <int PASS>
__device__ __forceinline__ void phase_s5(const Args& a, LAS unsigned char* lds, int gw, int NGW, int wave, int lane) {
    constexpr int WL = S5_WAVE_LDS + 512;
    LAS float* bu = (LAS float*)(lds + wave * WL); LAS bf16* sst = (LAS bf16*)(lds + wave * WL + 16 * S5_BU_STRIDE * 4); LAS bf16* ust = (LAS bf16*)(lds + wave * WL + S5_WAVE_LDS);
    const bf16* XN = (const bf16*)(a.ws + WS_XN); const f32x2* CIN = (const f32x2*)(a.ws + WS_CIN);
    const int g = gw & 63, slot = gw >> 6, nslots = NGW >> 6, n = lane & 15, kq = lane >> 4;
    if (slot >= nslots) return;
    S5Ops of, ob; s5_build<PASS, 0>(a, g, lane, of); s5_build<PASS, 1>(a, g, lane, ob);
    const float dsk = (PASS == 2) ? a.in[35][g * 16 + n] : 0.f;
    constexpr int NPAIR = NB * S5_NCH;
    v4u nA[4]; f32x2 ncf = {0.f, 0.f}, ncb = {0.f, 0.f};
#define S5_PREFETCH(pi_) do { const int b_ = (pi_) >> 7, ch_ = (pi_) & (S5_NCH - 1); const size_t r0_ = (size_t)(b_ * T + ch_ * S5_LC + n) * 1024 + g * 16 + kq * 8; \
        _Pragma("unroll") for (int q_ = 0; q_ < 4; ++q_) { nA[q_] = (v4u){0u, 0u, 0u, 0u}; if (kq < 2) nA[q_] = *(const v4u*)(XN + r0_ + (size_t)q_ * S5_SC * 1024); } \
        if (PASS == 2) { const size_t e_ = ((((size_t)b_) * 64 + g) * S5_NCH + ch_) * 64 + lane; ncf = CIN[e_]; ncb = CIN[e_ + (size_t)NB * 64 * S5_NCH * 64]; } } while (0)
    if (slot < NPAIR) S5_PREFETCH(slot);
    for (int pi = slot; pi < NPAIR; pi += nslots) { const int b = pi >> 7, chunk = pi & (S5_NCH - 1);
        asm volatile("s_waitcnt vmcnt(0)" ::: "memory");
        v4u cA[4];
#pragma unroll
        for (int q = 0; q < 4; ++q) cA[q] = nA[q];
        const f32x2 ccf = ncf, ccb = ncb;
        if (pi + nslots < NPAIR) S5_PREFETCH(pi + nslots);
        f32x4 yf[4];
#pragma unroll
        for (int i = 0; i < 4; ++i) yf[i] = (f32x4){0.f, 0.f, 0.f, 0.f};
        const int tok0 = b * T + chunk * S5_LC; const size_t e0 = ((((size_t)b) * 64 + g) * S5_NCH + chunk) * 64 + lane;
        s5_dir<PASS, 0>(a, of, bu, sst, ust, tok0, e0, g, lane, cA, ccf, dsk, yf);
        s5_dir<PASS, 1>(a, ob, bu, sst, ust, tok0, e0 + (size_t)NB * 64 * S5_NCH * 64, g, lane, cA, ccb, dsk, yf);
    }
#undef S5_PREFETCH
}
__device__ __forceinline__ void phase_s5_prefix(const Args& a, int gw, int NGW, int lane) {
    const f32x2* E = (const f32x2*)(a.ws + WS_E); f32x2* CIN = (f32x2*)(a.ws + WS_CIN);
    for (int u = gw; u < 2 * NB * 64; u += NGW) { const int g = u & 63, dir = u / (NB * 64);
        float lbr, lbi, cr, ci; s5_consts(a, g, lane, dir, lbr, lbi, cr, ci);
#pragma unroll
        for (int i = 0; i < 6; ++i) { const float r2 = lbr * lbr - lbi * lbi, i2 = 2.0f * lbr * lbi; lbr = r2; lbi = i2; }
        const size_t base = (size_t)u * S5_NCH * 64 + lane;
        float cre = 0.f, cim = 0.f;
        for (int k0 = 0; k0 < S5_NCH; k0 += 16) {
            f32x2 e[16];
#pragma unroll
            for (int i = 0; i < 16; ++i) { const int c = dir ? S5_NCH - 1 - (k0 + i) : (k0 + i); e[i] = E[base + (size_t)c * 64]; }
            asm volatile("s_waitcnt vmcnt(0)" ::: "memory");
#pragma unroll
            for (int i = 0; i < 16; ++i) { const int c = dir ? S5_NCH - 1 - (k0 + i) : (k0 + i);
                CIN[base + (size_t)c * 64] = (f32x2){cre, cim};
                const float nr = lbr * cre - lbi * cim + e[i].x, ni = lbr * cim + lbi * cre + e[i].y; cre = nr; cim = ni; }
        }
    }
}
#ifndef SKIPMASK
#define SKIPMASK 0
#endif
#define ON(n) (!((SKIPMASK >> (n)) & 1))
typedef const __attribute__((address_space(4))) Args* KArgP;
#define PHASE_BEGIN() \
    KArgP ap_ = (KArgP)__builtin_amdgcn_kernarg_segment_ptr(); asm volatile("" : "+s"(ap_)); const Args a = *ap_; \
    int tid = threadIdx.x; asm volatile("" : "+v"(tid)); const int lane = tid & 63, wave = __builtin_amdgcn_readfirstlane(tid >> 6); \
    int bx = blockIdx.x; asm volatile("" : "+s"(bx)); int G = gridDim.x; asm volatile("" : "+s"(G)); \
    const int gw = bx * NWAVES + wave, NGW = G * NWAVES; unsigned char* const ws = a.ws; \
    (void)lane; (void)gw; (void)NGW; (void)ws; (void)tid

__global__ void __launch_bounds__(NTHREADS, 2) mega_fwd(Args a_unused) {
#if defined(__HIP_DEVICE_COMPILE__)
    extern __shared__ __attribute__((aligned(16))) unsigned char lds_raw[];
    cg::grid_group grid = cg::this_grid();
    LAS unsigned char* const lds = (LAS unsigned char*)lds_raw;
    if (threadIdx.x < 4) ((LAS unsigned*)(lds + LDS_BARST))[threadIdx.x] = 0u;
    __syncthreads();
    XcdBarrier xbar; xbar.bar = nullptr; xbar.x = 0; xbar.st = nullptr;

    if (ON(0)) { PHASE_BEGIN();
        bf16* WIN = (bf16*)(ws + WS_WIN); bf16* WLORA = (bf16*)(ws + WS_WLORA); bf16* XN = (bf16*)(ws + WS_XN);
        LAS float* scr = (LAS float*)(lds + wave * 16384);
        if (bx == 0) { if (tid < 64) ((unsigned*)(ws + WS_CTL))[tid] = 0u; for (int i = tid; i < XCD_BAR_WORDS; i += NTHREADS) ((unsigned*)(ws + WS_BAR))[i] = 0u; }
        {
            const int nblk = 2624 / 32, nit = 16 * nblk;
            for (int it = gw; it < nit; it += NGW) { const int kb = it / nblk, nb = it % nblk; const int drow = nb < 58 ? 768 + 32 * nb : 32 * (nb - 58);
                transpose_item(a.in[6], 2624, WIN, 1024, 64 * kb, 32 * nb, drow, scr, lane); }
        }
        transpose_matrix(a.in[22], 1024, 1024, (bf16*)(ws + WS_WOUT), scr, gw, NGW, lane);
        transpose_matrix(a.in[36], 1024, 1024, (bf16*)(ws + WS_WGLU), scr, gw, NGW, lane);
        transpose_matrix(a.in[4], 1024, 4096, (bf16*)(ws + WS_WUP), scr, gw, NGW, lane);
        transpose_matrix(a.in[5], 4096, 1024, (bf16*)(ws + WS_WDN), scr, gw, NGW, lane);
        for (int i = bx * NTHREADS + tid; i < (NIN - 2624) * 1024 / 8; i += G * NTHREADS) *(v4u*)(WIN + (size_t)2624 * 1024 + (size_t)i * 8) = (v4u){0u, 0u, 0u, 0u};
        for (int i = bx * NTHREADS + tid; i < NLORA * KLORA; i += G * NTHREADS) { const int n = i / KLORA, k = i % KLORA; const int which = n >> 9, nn = n & 511; float v = 0.f;
            if (which == 0) { if (k < 64) v = a.in[9][k * 512 + nn]; }
            else if (which == 1) { if (k >= 64 && k < 128) v = a.in[11][(k - 64) * 512 + nn]; }
            else if (which == 2) { if (k >= 128 && k < 192) v = a.in[13][(k - 128) * 512 + nn]; }
            else { if (k >= 192 && k < 320) v = a.in[14][(k - 192) * 512 + nn]; }
            WLORA[i] = (bf16)(pk2(v, 0.f) & 0xffffu); }
        for (int i = bx * NTHREADS + tid; i < NLORA; i += G * NTHREADS) { const int which = i >> 9, nn = i & 511; ((float*)(ws + WS_LBIAS))[i] = which == 0 ? a.in[8][nn] : (which == 1 ? a.in[10][nn] : (which == 2 ? a.in[12][nn] : 0.f)); }
        rms_all(a.in[0], a.in[1], MPROMPT, a.in[2], XN, gw, NGW, lane);
    }
    grid.sync();
    { PHASE_BEGIN(); xbar = xcd_barrier_post((unsigned*)(ws + WS_BAR), (volatile LAS unsigned*)(lds + LDS_BARST)); }
    if (ON(1)) { PHASE_BEGIN();
        pg8::Gemm g{(const bf16*)(ws + WS_XN), (const bf16*)(ws + WS_WIN), M, NIN, D, D}; pg8::StaticOrder S; S.init(M, NIN, G, bx);
        pg8::EpiInProj E{(bf16*)(ws + WS_QKV), (bf16*)a.out};
        pg8::gemm_phase<pg8::EpiInProj, pg8::StaticOrder, true, true>(lds, g, S, E);
    }
    xcd_barrier(xbar);
    if (ON(2)) { PHASE_BEGIN(); phase_shift_qk(a, gw, NGW, lane); }
    xcd_barrier(xbar);
    if (ON(3)) { PHASE_BEGIN();
        pg8::Gemm g{(const bf16*)(ws + WS_A2), (const bf16*)(ws + WS_WLORA), M, NLORA, KLORA, KLORA}; pg8::StaticOrder S; S.init(M, NLORA, G, bx);
        pg8::EpiLora E{(bf16*)a.out, (size_t)M * 512, (const float*)(ws + WS_LBIAS)};
        pg8::gemm_phase<pg8::EpiLora, pg8::StaticOrder, true, true>(lds, g, S, E);
    }
    xcd_barrier(xbar);
    if (ON(4)) { PHASE_BEGIN();
        bf16* QKV = (bf16*)(ws + WS_QKV);
        const attn_body::bf16* Qp = (const attn_body::bf16*)(QKV + 512); const attn_body::bf16* Kp = (const attn_body::bf16*)(QKV + 1024); const attn_body::bf16* Vp = (const attn_body::bf16*)(QKV + 1152);
        attn_body::bf16* Op = (attn_body::bf16*)(QKV + 512);
        unsigned* ctr = (unsigned*)(ws + WS_CTL);
        volatile LAS unsigned* qw = (volatile LAS unsigned*)(lds + LDS_QWORD);
        for (;;) {
            if (tid == 0) *qw = __hip_atomic_fetch_add(ctr, 1u, __ATOMIC_RELAXED, __HIP_MEMORY_SCOPE_AGENT);
            __syncthreads();
            const int id = (int)__builtin_amdgcn_readfirstlane(*qw);
            __syncthreads();
            if (id >= 192 + 1536) break;
            if (id < 192) rwkv_chain(a, lds, id, tid, wave, lane);
            else { const int u = id - 192; const int bk = u >> 7, rem = u & 127; const int b = bk >> 1, h = (bk & 1) * 4 + (rem >> 5), qb = rem & 31;
                attn_body::attn_unit<8>(b, h, qb, Qp, Kp, Vp, Op, (char*)lds_raw); }
        }
    }
    xcd_barrier(xbar);
    if (ON(6)) { PHASE_BEGIN(); phase_post(a, gw, NGW, lane); }
    xcd_barrier(xbar);
    if (ON(7)) { PHASE_BEGIN();
        pg8::Gemm g{(const bf16*)(ws + WS_QKV), (const bf16*)(ws + WS_WOUT), M, D, D, 1280}; pg8::StaticOrder S; S.init(M, D, G, bx);
        pg8::EpiRes<0> E{a.in[0], a.in[1], a.out, nullptr, nullptr};
        pg8::gemm_phase<pg8::EpiRes<0>, pg8::StaticOrder, true, true>(lds, g, S, E);
    }
    xcd_barrier(xbar);
#pragma unroll
    for (int layer = 0; layer < 2; ++layer) {
        if (ON(8) && layer == 1) {
            { PHASE_BEGIN(); bf16* XN = (bf16*)(ws + WS_XN); LAS float* scr = (LAS float*)(lds + wave * 16384);
              rms_all(a.out, a.out, M, a.in[2] + D, XN, gw, NGW, lane);
              transpose_matrix(a.in[4] + (size_t)D * FF, 1024, 4096, (bf16*)(ws + WS_WUP), scr, gw, NGW, lane);
              transpose_matrix(a.in[5] + (size_t)D * FF, 4096, 1024, (bf16*)(ws + WS_WDN), scr, gw, NGW, lane); }
            xcd_barrier(xbar);
            if (ON(9)) { PHASE_BEGIN(); phase_s5<1>(a, lds, gw, NGW, wave, lane); }
            xcd_barrier(xbar);
            if (ON(10)) { PHASE_BEGIN(); phase_s5_prefix(a, gw, NGW, lane); }
            xcd_barrier(xbar);
            if (ON(11)) { PHASE_BEGIN(); phase_s5<2>(a, lds, gw, NGW, wave, lane); }
            xcd_barrier(xbar);
            if (ON(12)) { PHASE_BEGIN();
                pg8::Gemm g{(const bf16*)(ws + WS_Z), (const bf16*)(ws + WS_WGLU), M, D, D, D}; pg8::StaticOrder S; S.init(M, D, G, bx);
                pg8::EpiRes<2> E{nullptr, nullptr, a.out, (const bf16*)(ws + WS_Z), a.in[37]};
                pg8::gemm_phase<pg8::EpiRes<2>, pg8::StaticOrder, true, true>(lds, g, S, E);
            }
            xcd_barrier(xbar);
        }
        { PHASE_BEGIN(); bf16* XN = (bf16*)(ws + WS_XN); rms_all(a.out, a.out, M, a.in[3] + layer * D, XN, gw, NGW, lane); }
        xcd_barrier(xbar);
        if (ON(13)) { PHASE_BEGIN();
            pg8::Gemm g{(const bf16*)(ws + WS_XN), (const bf16*)(ws + WS_WUP), M, FF, D, D}; pg8::StaticOrder S; S.init(M, FF, G, bx);
            pg8::EpiUp E{(bf16*)(ws + WS_HID)};
            pg8::gemm_phase<pg8::EpiUp, pg8::StaticOrder, true, true>(lds, g, S, E);
        }
        xcd_barrier(xbar);
        if (ON(14)) { PHASE_BEGIN();
            pg8::Gemm g{(const bf16*)(ws + WS_HID), (const bf16*)(ws + WS_WDN), M, D, FF, FF}; pg8::StaticOrder S; S.init(M, D, G, bx);
            pg8::EpiRes<1> E{nullptr, nullptr, a.out, nullptr, nullptr};
            pg8::gemm_phase<pg8::EpiRes<1>, pg8::StaticOrder, true, true>(lds, g, S, E);
        }
        if (layer == 0) xcd_barrier(xbar);
    }
#endif
}

extern "C" void kernel_launch(void* const* d_in, const int* in_sizes, int n_in, void* d_out, int out_size, void* d_ws, size_t ws_size, hipStream_t stream) {
    static int grid = 0;
    if (grid == 0) {
        if (n_in != 38 || out_size != M * D || ws_size < WS_END) { fprintf(stderr, "kernel_launch: unexpected shapes: n_in %d out %d ws %zu\n", n_in, out_size, ws_size); grid = -1; return; }
        int dev = 0, cus = 0, per_cu = 0;
        if (hipGetDevice(&dev) != hipSuccess || hipDeviceGetAttribute(&cus, hipDeviceAttributeMultiprocessorCount, dev) != hipSuccess) { fprintf(stderr, "kernel_launch: device query failed\n"); grid = -1; return; }
        if (hipFuncSetAttribute((const void*)mega_fwd, hipFuncAttributeMaxDynamicSharedMemorySize, LDS_BYTES) != hipSuccess) { fprintf(stderr, "kernel_launch: hipFuncSetAttribute failed\n"); grid = -1; return; }
        if (hipOccupancyMaxActiveBlocksPerMultiprocessor(&per_cu, (const void*)mega_fwd, NTHREADS, LDS_BYTES) != hipSuccess || per_cu < 1) { fprintf(stderr, "kernel_launch: occupancy query says %d\n", per_cu); per_cu = 1; }
        (void)hipGetLastError();
        grid = cus * per_cu;
    }
    if (grid < 0) return;
    Args a{};
    for (int i = 0; i < 38; ++i) a.in[i] = (const float*)d_in[i];
    a.out = (float*)d_out; a.ws = (unsigned char*)d_ws;
    void* args[] = {&a};
    hipError_t e = hipLaunchCooperativeKernel((const void*)mega_fwd, dim3(grid), dim3(NTHREADS), args, LDS_BYTES, stream);
    if (e != hipSuccess) fprintf(stderr, "cooperative launch failed: %s (grid %d)\n", hipGetErrorString(e), grid);
}
```
